# Optimizing an MI355X kernel written in HIP

```python
import math
import jax
import jax.numpy as jnp
from jax import lax
import numpy as np

D_MODEL = 2048
BATCH = 1
SEQ = 8192
DEPTH = 4

HEAD_DIM = 128
MIX_HEADS = D_MODEL // HEAD_DIM
FOX_HEADS = MIX_HEADS // 4
SWA_HEADS = MIX_HEADS // 2
SWA_KV_HEADS = SWA_HEADS // 4
GLA_HEADS = MIX_HEADS - FOX_HEADS - SWA_HEADS
GLA_DK = HEAD_DIM // 2
GLA_DV = HEAD_DIM
GLA_GATE_RANK = 16
GLA_TAU = 16.0
GLA_CHUNK = 64
MIX_WIDTH = MIX_HEADS * HEAD_DIM
Q_BLOCK = 128
SWA_WINDOW = 128
NUM_BUCKETS = 32
T5_MAX_DISTANCE = 128
XATTN_HEADS = 4
MEM_LEN = 256
D_FF = ((8 * D_MODEL // 3 + 255) // 256) * 256
CONV_WIDTH = 3
EPS = 1e-6

IN_SPLITS = (FOX_HEADS * HEAD_DIM, FOX_HEADS * HEAD_DIM, FOX_HEADS * HEAD_DIM, FOX_HEADS,
             SWA_HEADS * HEAD_DIM, SWA_KV_HEADS * HEAD_DIM, SWA_KV_HEADS * HEAD_DIM,
             GLA_HEADS * GLA_DK, GLA_HEADS * GLA_DK, GLA_HEADS * GLA_DV, GLA_HEADS * GLA_DV,
             GLA_GATE_RANK)
IN_COLS = sum(IN_SPLITS)
IN_SPLIT_POINTS = tuple(int(v) for v in np.cumsum(IN_SPLITS)[:-1])

kernel_name = 'hybrid_fox_swa_gla_trunk'


def rms_norm(x, g):
    xf = x.astype(jnp.float32)
    y = xf * lax.rsqrt(jnp.mean(xf * xf, axis=-1, keepdims=True) + EPS)
    return (y * g.astype(jnp.float32)).astype(x.dtype)


def fox_attention(q, k, v, f_logit):
    B, H, T, Dh = q.shape
    nb = T // Q_BLOCK
    c = jnp.cumsum(jax.nn.log_sigmoid(f_logit.astype(jnp.float32)), axis=-1)
    qb = q.reshape(B, H, nb, Q_BLOCK, Dh).transpose(2, 0, 1, 3, 4)
    cb = c.reshape(B, H, nb, Q_BLOCK).transpose(2, 0, 1, 3)
    kpos = jnp.arange(T)
    scale = Dh ** -0.5

    def block(args):
        qi, ci, i = args
        s = jnp.einsum('bhqd,bhkd->bhqk', qi, k).astype(jnp.float32) * scale
        s = s + ci[..., None] - c[:, :, None, :]
        qpos = i * Q_BLOCK + jnp.arange(Q_BLOCK)
        s = jnp.where(kpos[None, :] <= qpos[:, None], s, -jnp.inf)
        p = jax.nn.softmax(s, axis=-1).astype(v.dtype)
        return jnp.einsum('bhqk,bhkd->bhqd', p, v)

    o = lax.map(block, (qb, cb, jnp.arange(nb)))
    return o.transpose(1, 2, 0, 3, 4).reshape(B, H, T, Dh)


def t5_bucket(rel):
    n = jnp.maximum(rel, 0)
    max_exact = NUM_BUCKETS // 2
    nf = jnp.maximum(n, 1).astype(jnp.float32)
    large = max_exact + (jnp.log(nf / max_exact) / math.log(T5_MAX_DISTANCE / max_exact)
                         * (NUM_BUCKETS - max_exact)).astype(jnp.int32)
    large = jnp.minimum(large, NUM_BUCKETS - 1)
    return jnp.where(n < max_exact, n, large)


def swa_attention(q, k, v, sinks, t5_bias):
    B, Hq, T, Dh = q.shape
    Hkv = k.shape[1]
    G = Hq // Hkv
    W = SWA_WINDOW
    nb = T // W
    qb = q.reshape(B, Hkv, G, nb, W, Dh)

    def band(a):
        ab = a.reshape(B, Hkv, nb, W, Dh)
        prev = jnp.pad(ab[:, :, :-1], ((0, 0), (0, 0), (1, 0), (0, 0), (0, 0)))
        return jnp.concatenate([prev, ab], axis=3)

    kb, vb = band(k), band(v)
    s = jnp.einsum('bhgnqd,bhnkd->bhgnqk', qb, kb).astype(jnp.float32) * (Dh ** -0.5)
    i = jnp.arange(W)
    j = jnp.arange(2 * W)
    rel = (W + i)[:, None] - j[None, :]
    bias = t5_bias[t5_bucket(rel)].astype(jnp.float32)
    bias = jnp.transpose(bias, (2, 0, 1)).reshape(Hkv, G, 1, W, 2 * W)
    s = s + bias
    in_window = (rel >= 0) & (rel < W)
    blk = jnp.arange(nb)
    valid = in_window[None] & ((blk[:, None, None] > 0) | (j[None, None, :] >= W))
    s = jnp.where(valid, s, -jnp.inf)
    sink = jnp.broadcast_to(sinks.astype(jnp.float32).reshape(1, Hkv, G, 1, 1, 1), s.shape[:-1] + (1,))
    p = jax.nn.softmax(jnp.concatenate([s, sink], axis=-1), axis=-1)[..., :-1].astype(v.dtype)
    o = jnp.einsum('bhgnqk,bhnkd->bhgnqd', p, vb)
    return o.reshape(B, Hq, T, Dh)


def gla_chunked(q, k, v, log_a):
    B, H, T, dk = q.shape
    dv = v.shape[-1]
    C = GLA_CHUNK
    nc = T // C
    f32 = jnp.float32
    qc = (q.astype(f32) * (dk ** -0.5)).reshape(B, H, nc, C, dk)
    kc = k.astype(f32).reshape(B, H, nc, C, dk)
    vc = v.astype(f32).reshape(B, H, nc, C, dv)
    gc = log_a.astype(f32).reshape(B, H, nc, C, dk)
    b = jnp.cumsum(gc, axis=3)
    b_last = b[:, :, :, -1:, :]
    q_t = qc * jnp.exp(b)
    k_t = kc * jnp.exp(-b)
    k_end = kc * jnp.exp(b_last - b)
    causal = jnp.tril(jnp.ones((C, C), dtype=bool))
    A = jnp.where(causal, jnp.einsum('bhnqd,bhnkd->bhnqk', q_t, k_t), 0.0)
    o_intra = jnp.einsum('bhnqk,bhnkd->bhnqd', A, vc)
    kv = jnp.einsum('bhnkd,bhnke->bhnde', k_end, vc)
    decay = jnp.exp(b_last[:, :, :, 0, :])

    def step(S, inp):
        dec, kv_n = inp
        return dec[..., None] * S + kv_n, S

    S0 = jnp.zeros((B, H, dk, dv), f32)
    _, S_prev = lax.scan(step, S0, (jnp.moveaxis(decay, 2, 0), jnp.moveaxis(kv, 2, 0)))
    S_prev = jnp.moveaxis(S_prev, 0, 2)
    o_inter = jnp.einsum('bhnqd,bhnde->bhnqe', q_t, S_prev)
    return (o_intra + o_inter).reshape(B, H, T, dv).astype(v.dtype)


def hybrid_mixer(xn, w_in, b_f, sinks, t5_bias, w_gate, b_gate, gla_g, w_out):
    B, T, _ = xn.shape
    proj = xn @ w_in
    (fq, fk, fv, ff, sq, sk, sv, gq, gk, gv, gr, glr) = jnp.split(proj, IN_SPLIT_POINTS, axis=-1)

    def heads(a, n):
        return a.reshape(B, T, n, -1).transpose(0, 2, 1, 3)

    def merge(a):
        return a.transpose(0, 2, 1, 3).reshape(B, T, -1)

    o_fox = fox_attention(heads(fq, FOX_HEADS), heads(fk, FOX_HEADS), heads(fv, FOX_HEADS),
                          (ff + b_f).transpose(0, 2, 1))
    o_swa = swa_attention(heads(sq, SWA_HEADS), heads(sk, SWA_KV_HEADS), heads(sv, SWA_KV_HEADS),
                          sinks, t5_bias)
    log_a = jax.nn.log_sigmoid((glr @ w_gate + b_gate).astype(jnp.float32)) / GLA_TAU
    o_gla = gla_chunked(heads(gq, GLA_HEADS), heads(gk, GLA_HEADS), heads(gv, GLA_HEADS),
                        heads(log_a, GLA_HEADS))
    o_gla = merge(rms_norm(o_gla, gla_g)) * jax.nn.silu(gr)
    o = jnp.concatenate([merge(o_fox), merge(o_swa), o_gla], axis=-1)
    return o @ w_out


def cross_attention(xn, memn, wq, wkv, wo):
    B, T, _ = xn.shape
    M = memn.shape[1]
    q = (xn @ wq).reshape(B, T, XATTN_HEADS, HEAD_DIM)
    k, v = jnp.split((memn @ wkv).reshape(B, M, 2 * XATTN_HEADS, HEAD_DIM), 2, axis=2)
    s = jnp.einsum('bthd,bmhd->bhtm', q, k).astype(jnp.float32) * (HEAD_DIM ** -0.5)
    p = jax.nn.softmax(s, axis=-1).astype(v.dtype)
    o = jnp.einsum('bhtm,bmhd->bthd', p, v).reshape(B, T, XATTN_HEADS * HEAD_DIM)
    return o @ wo


def conv_ffn(xn, w_up, conv_w, conv_b, w_down):
    T = xn.shape[1]
    u = xn @ w_up
    up = jnp.pad(u, ((0, 0), (CONV_WIDTH - 1, 0), (0, 0)))
    uc = conv_b + conv_w[CONV_WIDTH - 1] * u
    for j in range(CONV_WIDTH - 1):
        uc = uc + conv_w[j] * up[:, j:j + T]
    gate, val = jnp.split(uc, 2, axis=-1)
    return (jax.nn.silu(gate) * val) @ w_down


def setup_inputs(seed: int = 0) -> dict:
    key = jax.random.key(seed)
    ks = jax.random.split(key, 24)
    nrm = jax.random.normal
    f32 = jnp.float32
    XW = XATTN_HEADS * HEAD_DIM
    return {
        'x': nrm(ks[0], (BATCH, SEQ, D_MODEL), f32),
        'mem': nrm(ks[1], (BATCH, MEM_LEN, D_MODEL), f32),
        'w_in': nrm(ks[2], (DEPTH, D_MODEL, IN_COLS), f32) * D_MODEL ** -0.5,
        'b_fox_f': 3.0 + 0.5 * nrm(ks[3], (DEPTH, FOX_HEADS), f32),
        'swa_sinks': 0.5 * nrm(ks[4], (DEPTH, SWA_HEADS), f32),
        't5_bias': 0.5 * nrm(ks[5], (NUM_BUCKETS, SWA_HEADS), f32),
        'w_gla_gate': nrm(ks[6], (DEPTH, GLA_GATE_RANK, GLA_HEADS * GLA_DK), f32) * GLA_GATE_RANK ** -0.5,
        'b_gla_gate': 0.1 * nrm(ks[7], (DEPTH, GLA_HEADS * GLA_DK), f32),
        'gla_norm': 1.0 + 0.02 * nrm(ks[8], (DEPTH, GLA_DV), f32),
        'w_mix_out': nrm(ks[9], (DEPTH, MIX_WIDTH, D_MODEL), f32) * MIX_WIDTH ** -0.5,
        'norm_mix': 1.0 + 0.02 * nrm(ks[10], (DEPTH, D_MODEL), f32),
        'norm_xattn': 1.0 + 0.02 * nrm(ks[11], (DEPTH, D_MODEL), f32),
        'norm_mem': 1.0 + 0.02 * nrm(ks[12], (DEPTH, D_MODEL), f32),
        'wq_x': nrm(ks[13], (DEPTH, D_MODEL, XW), f32) * D_MODEL ** -0.5,
        'wkv_x': nrm(ks[14], (DEPTH, D_MODEL, 2 * XW), f32) * D_MODEL ** -0.5,
        'wo_x': nrm(ks[15], (DEPTH, XW, D_MODEL), f32) * XW ** -0.5,
        'norm_ffn': 1.0 + 0.02 * nrm(ks[16], (DEPTH, D_MODEL), f32),
        'w_up': nrm(ks[17], (DEPTH, D_MODEL, 2 * D_FF), f32) * D_MODEL ** -0.5,
        'conv_w': nrm(ks[18], (DEPTH, CONV_WIDTH, 2 * D_FF), f32) * CONV_WIDTH ** -0.5,
        'conv_b': 0.02 * nrm(ks[19], (DEPTH, 2 * D_FF), f32),
        'w_down': nrm(ks[20], (DEPTH, D_FF, D_MODEL), f32) * D_FF ** -0.5,
        'final_norm': 1.0 + 0.02 * nrm(ks[21], (D_MODEL,), f32),
    }


def reference(x, mem, w_in, b_fox_f, swa_sinks, t5_bias, w_gla_gate, b_gla_gate, gla_norm,
              w_mix_out, norm_mix, norm_xattn, norm_mem, wq_x, wkv_x, wo_x, norm_ffn,
              w_up, conv_w, conv_b, w_down, final_norm):
    h = x
    for l in range(DEPTH):
        h = h + hybrid_mixer(rms_norm(h, norm_mix[l]), w_in[l], b_fox_f[l], swa_sinks[l], t5_bias,
                             w_gla_gate[l], b_gla_gate[l], gla_norm[l], w_mix_out[l])
        h = h + cross_attention(rms_norm(h, norm_xattn[l]), rms_norm(mem, norm_mem[l]),
                                wq_x[l], wkv_x[l], wo_x[l])
        h = h + conv_ffn(rms_norm(h, norm_ffn[l]), w_up[l], conv_w[l], conv_b[l], w_down[l])
    return rms_norm(h, final_norm)
```

```cpp
#include <hip/hip_runtime.h>
#include <hip/hip_cooperative_groups.h>
#include <cstdio>
#include <cstdint>
namespace cg = cooperative_groups;

#define LAS __attribute__((address_space(3)))
typedef unsigned short bf16_t;
typedef short bf16x8 __attribute__((ext_vector_type(8)));
typedef float f32x4 __attribute__((ext_vector_type(4)));
typedef float f32x16 __attribute__((ext_vector_type(16)));
typedef unsigned u32x4 __attribute__((ext_vector_type(4)));
typedef unsigned u32x2 __attribute__((ext_vector_type(2)));

constexpr int T_ = 8192, D_ = 2048, L_ = 4, FF_ = 5632, INC = 4628, MEM_ = 256;
constexpr int NP = 3584;
constexpr int PJ_FQ = 0, PJ_FK = 512, PJ_SQ = 1024, PJ_SK = 2048, PJ_GQ = 2304, PJ_GK = 2560, PJ_GR = 2816, PJ_GT = 3328;
constexpr int VT_F = 0, VT_S = 512, VT_G = 768, NVT = 1280;
constexpr int NWIN = NP + NVT;
constexpr float EPS = 1e-6f, LOG2E = 1.4426950408889634f;
constexpr float NEG = -1e30f;

constexpr size_t MiB = 1ull << 20;
constexpr size_t SZ_WIN = (size_t)NWIN * D_ * 2, SZ_WOUT = (size_t)D_ * D_ * 2, SZ_WQ = 512ull * D_ * 2, SZ_WKV = 1024ull * D_ * 2,
                 SZ_WO = (size_t)D_ * 512 * 2, SZ_WUP = 2ull * FF_ * D_ * 2, SZ_WDN = (size_t)D_ * FF_ * 2;
constexpr size_t OF_WIN = 0, OF_WOUT = OF_WIN + SZ_WIN, OF_WQ = OF_WOUT + SZ_WOUT, OF_WKV = OF_WQ + SZ_WQ, OF_WO = OF_WKV + SZ_WKV,
                 OF_WUP = OF_WO + SZ_WO, OF_WDN = OF_WUP + SZ_WUP, SZ_LAYER = OF_WDN + SZ_WDN;
constexpr size_t WS_SSQ = 1 * MiB;
constexpr size_t WS_W = 2 * MiB;
constexpr size_t WS_H = WS_W + ((4 * SZ_LAYER + MiB - 1) / MiB) * MiB;
constexpr size_t WS_HB = WS_H + 64 * MiB;
constexpr size_t WS_PROJ = WS_HB + 32 * MiB;
constexpr size_t WS_GATES = WS_PROJ + 56 * MiB;
constexpr size_t WS_VT = WS_GATES + 1 * MiB;
constexpr size_t WS_O = WS_VT + 20 * MiB;
constexpr size_t WS_QX = WS_O + 32 * MiB;
constexpr size_t WS_XO = WS_QX + 8 * MiB;
constexpr size_t WS_KX = WS_XO + 8 * MiB;
constexpr size_t WS_VXT = WS_KX + 1 * MiB;
constexpr size_t WS_MEMB = WS_VXT + 1 * MiB;
constexpr size_t WS_U = WS_MEMB + 1 * MiB;
constexpr size_t WS_ACT = WS_U + 176 * MiB;
constexpr size_t WS_KVB = WS_ACT + 88 * MiB;
constexpr size_t WS_DEC = WS_KVB + 16 * MiB;
constexpr size_t WS_C = WS_DEC + 1 * MiB;
constexpr size_t WS_END = WS_C + 1 * MiB;

constexpr int LDS_BYTES = 147456;

struct Params {
    const float *x, *mem, *w_in, *b_fox_f, *swa_sinks, *t5_bias, *w_gla_gate, *b_gla_gate, *gla_norm, *w_mix_out, *norm_mix, *norm_xattn, *norm_mem,
        *wq_x, *wkv_x, *wo_x, *norm_ffn, *w_up, *conv_w, *conv_b, *w_down, *final_norm;
    float* out; unsigned char* ws;
};

__device__ __forceinline__ unsigned cvt_pk_bf16(float lo, float hi) { unsigned r; asm("v_cvt_pk_bf16_f32 %0, %1, %2" : "=v"(r) : "v"(lo), "v"(hi)); return r; }
__device__ __forceinline__ float bf2f(unsigned short b) { return __uint_as_float((unsigned)b << 16); }
__device__ __forceinline__ float bflo(unsigned w) { return __uint_as_float(w << 16); }
__device__ __forceinline__ float bfhi(unsigned w) { return __uint_as_float(w & 0xffff0000u); }
__device__ __forceinline__ float logsig(float x) { return fminf(x, 0.f) - __logf(1.f + __expf(-fabsf(x))); }
__device__ __forceinline__ float ex2(float x) { return __builtin_amdgcn_exp2f(x); }
__device__ __forceinline__ bf16x8 pack8(float a0, float a1, float a2, float a3, float a4, float a5, float a6, float a7) {
    u32x4 w; w.x = cvt_pk_bf16(a0, a1); w.y = cvt_pk_bf16(a2, a3); w.z = cvt_pk_bf16(a4, a5); w.w = cvt_pk_bf16(a6, a7);
    return __builtin_bit_cast(bf16x8, w);
}
__device__ __forceinline__ float shx(float v, int off, int lane) { return __int_as_float(__builtin_amdgcn_ds_bpermute((lane ^ off) << 2, __float_as_int(v))); }
__device__ __forceinline__ float xmax(float v) { const auto r = __builtin_amdgcn_permlane32_swap(__float_as_uint(v), __float_as_uint(v), false, false); return fmaxf(__uint_as_float(r[0]), __uint_as_float(r[1])); }
__device__ __forceinline__ float xsum(float v) { const auto r = __builtin_amdgcn_permlane32_swap(__float_as_uint(v), __float_as_uint(v), false, false); return __uint_as_float(r[0]) + __uint_as_float(r[1]); }
#define MFMA32(a, b, c) __builtin_amdgcn_mfma_f32_32x32x16_bf16((a), (b), (c), 0, 0, 0)

struct AB { const char* A; const char* B; };
namespace pg8 {
constexpr int BM = 256, BK = 64, HALF = 128, HTB = HALF * BK * 2, STAGE_BYTES = 8 * HTB;
__host__ __device__ __forceinline__ int lds_byte(int r, int c) { const int st = (r >> 4) * 2 + (c >> 5), rr = r & 15, cc = c & 31, ob = rr * 64 + cc * 2; return st * 1024 + (ob ^ (((ob >> 9) & 1) << 5)); }
__host__ __device__ __forceinline__ void stage_rc(int b, int& R, int& C) { const int st = b / 1024, sb = b % 1024, swz = sb ^ (((sb >> 9) & 1) << 5); R = (st >> 1) * 16 + swz / 64; C = (st & 1) * 32 + (swz % 64) / 2; }
__host__ __device__ __forceinline__ int perm32(int rho) { const int n = rho >> 4, i = rho & 15; return 8 * (i >> 2) + 4 * n + (i & 3); }

template <class Epi, class Sched, bool APERM = false>
__device__ __forceinline__ void gemm_phase(LAS unsigned char* lds, const int tid_in, const int K, const Sched& S, const Epi& E) {
    typedef typename Sched::Unit Unit;
    int tid = tid_in; asm volatile("" : "+v"(tid));
    const int wid = __builtin_amdgcn_readfirstlane(tid >> 6), lane = tid & 63, wr = wid >> 2, wc = wid & 3, fr = lane & 15, fq = lane >> 4;
    const int nt = K / BK;
    unsigned voffA[2], voffB[2];
#pragma unroll
    for (int i = 0; i < 2; ++i) { int R, C; stage_rc(tid * 16 + i * 8192, R, C); const int Rb = Epi::PERM ? ((R & ~31) + perm32(R & 31)) : R;
        const int Ra = APERM ? (128 * (R >> 6) + 8 * (R & 15) + ((R >> 4) & 3)) : R;
        voffA[i] = (unsigned)(Ra * K + C) * 2u; voffB[i] = (unsigned)(Rb * K + C) * 2u; }
    const size_t kstep = (size_t)(BK * 2);
    const size_t hstep = (size_t)HALF * K * 2;
    const size_t hstepA = APERM ? (size_t)4 * K * 2 : hstep;
    const unsigned ldsw = (unsigned)wid * 1024u;
    const int aoff = lds_byte(wr * 64 + fr, fq * 8), boff = lds_byte(wc * 32 + fr, fq * 8);
#define PG8_SA(b, h) (((b) * 2 + (h)) * HTB)
#define PG8_SB(b, h) ((4 + (b) * 2 + (h)) * HTB)
#define PG8_STAGE(bufoff, gbase, voff) do { _Pragma("unroll") for (int _i = 0; _i < 2; ++_i) \
        __builtin_amdgcn_global_load_lds((const unsigned*)((const char*)(gbase) + (voff)[_i]), (LAS unsigned*)(lds + (bufoff) + ldsw + _i * 8192), 16, 0, 0); } while (0)
#define PG8_LDA(dst, b, h) do { _Pragma("unroll") for (int m = 0; m < 4; ++m) _Pragma("unroll") for (int k = 0; k < 2; ++k) dst[m][k] = *(const LAS bf16x8*)(lds + PG8_SA(b, h) + aoff + m * 2048 + k * 1024); } while (0)
#define PG8_LDB(dst, b, h) do { _Pragma("unroll") for (int n = 0; n < 2; ++n) _Pragma("unroll") for (int k = 0; k < 2; ++k) dst[n][k] = *(const LAS bf16x8*)(lds + PG8_SB(b, h) + boff + n * 2048 + k * 1024); } while (0)
#define PG8_MMA(ai, bj, At, Bt) do { __builtin_amdgcn_s_setprio(1); _Pragma("unroll") for (int m = 0; m < 4; ++m) _Pragma("unroll") for (int n = 0; n < 2; ++n) _Pragma("unroll") for (int k = 0; k < 2; ++k) \
        acc[ai][bj][m][n] = __builtin_amdgcn_mfma_f32_16x16x32_bf16(Bt[n][k], At[m][k], acc[ai][bj][m][n], 0, 0, 0); __builtin_amdgcn_s_setprio(0); } while (0)
#define PG8_WAIT_V(n) asm volatile("s_waitcnt vmcnt(" #n ")" ::: "memory")
#define PG8_WAIT_L(n) asm volatile("s_waitcnt lgkmcnt(" #n ")" ::: "memory")
#define PG8_BAR __builtin_amdgcn_s_barrier()
#define PG8_SCHED __builtin_amdgcn_sched_barrier(0)
    AB cur, nxt; int ui = 0;
    if (!S.next(0, cur)) return;
    f32x4 acc[2][2][4][2];
#pragma unroll
    for (int a = 0; a < 2; ++a)
#pragma unroll
        for (int b = 0; b < 2; ++b)
#pragma unroll
            for (int m = 0; m < 4; ++m)
#pragma unroll
                for (int n = 0; n < 2; ++n) acc[a][b][m][n] = (f32x4){0.f, 0.f, 0.f, 0.f};
    bf16x8 At[4][2], B0[2][2], B1[2][2];
    const char* cA = cur.A; const char* cB = cur.B;
    PG8_STAGE(PG8_SB(0, 0), cB, voffB); PG8_STAGE(PG8_SB(0, 1), cB + hstep, voffB); PG8_STAGE(PG8_SA(0, 0), cA, voffA); PG8_STAGE(PG8_SA(0, 1), cA + hstepA, voffA);
    if (wr == 1) PG8_BAR;
    PG8_WAIT_V(2); PG8_BAR;
    PG8_STAGE(PG8_SB(1, 0), cB + kstep, voffB); PG8_STAGE(PG8_SA(1, 0), cA + kstep, voffA); PG8_STAGE(PG8_SB(1, 1), cB + hstep + kstep, voffB);
    PG8_WAIT_V(6); PG8_BAR;
    for (;;) {
        const bool has_next = S.next(ui + 1, nxt);
        const char* nA = has_next ? nxt.A : cA; const char* nB = has_next ? nxt.B : cB;
        for (int t = 0; t < nt; t += 2) {
            const bool last = (t == nt - 2);
            const char* a1 = cA + (size_t)(t + 1) * kstep;
            const char* a2 = last ? nA : cA + (size_t)(t + 2) * kstep; const char* b2 = last ? nB : cB + (size_t)(t + 2) * kstep;
            const char* a3 = a2 + kstep; const char* b3 = b2 + kstep;
            PG8_LDB(B0, 0, 0); PG8_LDB(B1, 0, 1); PG8_SCHED; PG8_LDA(At, 0, 0); PG8_STAGE(PG8_SA(1, 1), a1 + hstepA, voffA);
            PG8_WAIT_V(8); PG8_WAIT_L(0); PG8_BAR; PG8_MMA(0, 0, At, B0); PG8_MMA(0, 1, At, B1); PG8_BAR; PG8_SCHED;
            PG8_LDA(At, 0, 1); PG8_STAGE(PG8_SB(0, 0), b2, voffB); PG8_STAGE(PG8_SB(0, 1), b2 + hstep, voffB); PG8_STAGE(PG8_SA(0, 0), a2, voffA);
            PG8_WAIT_V(8); PG8_WAIT_L(0); PG8_BAR; PG8_MMA(1, 0, At, B0); PG8_MMA(1, 1, At, B1); PG8_BAR; PG8_SCHED;
            PG8_LDB(B0, 1, 0); PG8_LDB(B1, 1, 1); PG8_SCHED; PG8_LDA(At, 1, 0); PG8_STAGE(PG8_SA(0, 1), a2 + hstepA, voffA);
            PG8_WAIT_V(8); PG8_WAIT_L(0); PG8_BAR; PG8_MMA(0, 0, At, B0); PG8_MMA(0, 1, At, B1); PG8_BAR; PG8_SCHED;
            PG8_LDA(At, 1, 1); PG8_STAGE(PG8_SB(1, 0), b3, voffB); PG8_STAGE(PG8_SB(1, 1), b3 + hstep, voffB); PG8_STAGE(PG8_SA(1, 0), a3, voffA);
            PG8_WAIT_V(8); PG8_WAIT_L(0); PG8_BAR; PG8_MMA(1, 0, At, B0); PG8_MMA(1, 1, At, B1); PG8_BAR; PG8_SCHED;
        }
        if (wr == 0) PG8_BAR;
        { const Unit fu = S.full(ui); E(acc, fu, wr, wc, fr, fq); }
        if (!has_next) break;
#pragma unroll
        for (int a = 0; a < 2; ++a)
#pragma unroll
            for (int b = 0; b < 2; ++b)
#pragma unroll
                for (int m = 0; m < 4; ++m)
#pragma unroll
                    for (int n = 0; n < 2; ++n) acc[a][b][m][n] = (f32x4){0.f, 0.f, 0.f, 0.f};
        cur = nxt; cA = nA; cB = nB; ++ui;
        if (wr == 1) PG8_BAR;
    }
    PG8_WAIT_V(0);
    PG8_BAR;
#undef PG8_SA
#undef PG8_SB
#undef PG8_STAGE
#undef PG8_LDA
#undef PG8_LDB
#undef PG8_MMA
#undef PG8_WAIT_V
#undef PG8_WAIT_L
#undef PG8_BAR
#undef PG8_SCHED
}
}

typedef unsigned long long u64;
constexpr float SSQ_SCALE = 16777216.f, SSQ_INV = 1.f / (16777216.f * 2048.f);
__device__ __forceinline__ float u64f(u64 q) { return (float)(unsigned)(q >> 32) * 4294967296.f + (float)(unsigned)q; }
struct GU { bf16_t* out; const u64* sc; float* gates; int ldc; int mode; };

struct EpiB {
    static constexpr bool PERM = true;
    __device__ __forceinline__ void operator()(const f32x4 (&acc)[2][2][4][2], const GU& u, int wr, int wc, int fr, int fq) const {
        const int r0 = wr * 64 + fr, c0 = wc * 32 + 8 * fq;
        f32x4 cs[2][2];
#pragma unroll
        for (int bj = 0; bj < 2; ++bj)
#pragma unroll
            for (int n = 0; n < 2; ++n) {
                if (u.mode == 2) { const u64* q = u.sc + c0 + bj * 128 + 4 * n;
                    cs[bj][n] = (f32x4){rsqrtf(u64f(q[0]) * SSQ_INV + EPS), rsqrtf(u64f(q[1]) * SSQ_INV + EPS), rsqrtf(u64f(q[2]) * SSQ_INV + EPS), rsqrtf(u64f(q[3]) * SSQ_INV + EPS)}; }
                else cs[bj][n] = (f32x4){1.f, 1.f, 1.f, 1.f};
            }
        float rsv[2][4];
        if (u.mode == 1) { u64 q_[2][4];
#pragma unroll
            for (int ai = 0; ai < 2; ++ai)
#pragma unroll
                for (int m = 0; m < 4; ++m) q_[ai][m] = u.sc[r0 + ai * 128 + m * 16];
#pragma unroll
            for (int ai = 0; ai < 2; ++ai)
#pragma unroll
                for (int m = 0; m < 4; ++m) rsv[ai][m] = rsqrtf(u64f(q_[ai][m]) * SSQ_INV + EPS);
        } else {
#pragma unroll
            for (int ai = 0; ai < 2; ++ai)
#pragma unroll
                for (int m = 0; m < 4; ++m) rsv[ai][m] = 1.f;
        }
#pragma unroll
        for (int ai = 0; ai < 2; ++ai)
#pragma unroll
            for (int m = 0; m < 4; ++m) {
                const int row = r0 + ai * 128 + m * 16;
                const float rs = rsv[ai][m];
                bf16_t* rowp = u.out + (size_t)row * u.ldc + c0;
#pragma unroll
                for (int bj = 0; bj < 2; ++bj) {
                    f32x4 v0 = acc[ai][bj][m][0] * cs[bj][0] * rs, v1 = acc[ai][bj][m][1] * cs[bj][1] * rs;
                    u32x4 w; w.x = cvt_pk_bf16(v0[0], v0[1]); w.y = cvt_pk_bf16(v0[2], v0[3]); w.z = cvt_pk_bf16(v1[0], v1[1]); w.w = cvt_pk_bf16(v1[2], v1[3]);
                    *(u32x4*)(rowp + bj * 128) = w;
                    if (bj == 0 && u.gates != nullptr && wc == 0) { float* gp = u.gates + (size_t)row * 32 + 8 * fq; *(f32x4*)gp = v0; *(f32x4*)(gp + 4) = v1; }
                }
            }
    }
};

__device__ __forceinline__ void tile_order(int wgid, int nM, int nN, int& pm, int& pn) {
    const int nwg = nM * nN; { const int q = nwg / 8, r = nwg % 8, xcd = wgid % 8, off = wgid / 8; wgid = (xcd < r ? xcd * (q + 1) : r * (q + 1) + (xcd - r) * q) + off; }
    const int nig = 8 * nN, gid = wgid / nig, fm = gid * 8, gsz = (nM - fm) < 8 ? (nM - fm) : 8;
    pm = fm + ((wgid % nig) % gsz); pn = (wgid % nig) / gsz;
}

struct SchedIn {
    typedef GU Unit;
    unsigned char* ws; int l, nkv, G, c;
    __device__ __forceinline__ bool next(int i, AB& u) const {
        int Lx = i * G + c;
        const char* hb = (const char*)(ws + WS_HB); const char* wt = (const char*)(ws + WS_W + (size_t)l * SZ_LAYER + OF_WIN);
        if (Lx < 448) { int pm, pn; tile_order(Lx, 32, 14, pm, pn); u.A = hb + (size_t)pm * 256 * D_ * 2; u.B = wt + (size_t)pn * 256 * D_ * 2; return true; }
        Lx -= 448;
        if (Lx < 160) { const int pm = Lx % 5, pn = Lx / 5; u.A = wt + (size_t)(NP + pm * 256) * D_ * 2; u.B = hb + (size_t)pn * 256 * D_ * 2; return true; }
        Lx -= 160;
        if (Lx < nkv) { const int lk = Lx >> 2, j = Lx & 3; const char* w = (const char*)(ws + WS_W + OF_WKV + (size_t)lk * SZ_LAYER); const char* memb = (const char*)(ws + WS_MEMB);
            if (j < 2) { u.A = memb; u.B = w + (size_t)j * 256 * D_ * 2; } else { u.A = w + (size_t)(512 + (j - 2) * 256) * D_ * 2; u.B = memb; }
            return true; }
        return false;
    }
    __device__ __forceinline__ GU full(int i) const {
        GU u; int Lx = i * G + c; const u64* ssq = (const u64*)(ws + WS_SSQ) + (3 * l) * T_;
        if (Lx < 448) { int pm, pn; tile_order(Lx, 32, 14, pm, pn);
            u.out = (bf16_t*)(ws + WS_PROJ) + (size_t)pm * 256 * NP + pn * 256; u.sc = ssq + pm * 256;
            u.gates = (pn == 13) ? (float*)(ws + WS_GATES) + (size_t)pm * 256 * 32 : nullptr; u.ldc = NP; u.mode = 1; return u; }
        Lx -= 448;
        if (Lx < 160) { const int pm = Lx % 5, pn = Lx / 5;
            u.out = (bf16_t*)(ws + WS_VT) + (size_t)pm * 256 * T_ + pn * 256; u.sc = ssq + pn * 256; u.gates = nullptr; u.ldc = T_; u.mode = 2; return u; }
        Lx -= 160;
        { const int lk = Lx >> 2, j = Lx & 3; u.sc = nullptr; u.gates = nullptr; u.mode = 0;
            if (j < 2) { u.out = (bf16_t*)(ws + WS_KX) + (size_t)lk * 256 * 512 + j * 256; u.ldc = 512; }
            else { u.out = (bf16_t*)(ws + WS_VXT) + (size_t)lk * 512 * 256 + (size_t)(j - 2) * 256 * 256; u.ldc = 256; } }
        return u;
    }
};
struct SchedRow {
    typedef GU Unit;
    const char* A; const char* B; bf16_t* out; const u64* ssq; int nM, nN, K, G, c;
    __device__ __forceinline__ bool next(int i, AB& u) const {
        const int Lx = i * G + c; if (Lx >= nM * nN) return false;
        int pm, pn; tile_order(Lx, nM, nN, pm, pn);
        u.A = A + (size_t)pm * 256 * K * 2; u.B = B + (size_t)pn * 256 * K * 2; return true;
    }
    __device__ __forceinline__ GU full(int i) const {
        GU u; const int Lx = i * G + c; int pm, pn; tile_order(Lx, nM, nN, pm, pn);
        u.out = out + (size_t)pm * 256 * (nN * 256) + pn * 256; u.sc = ssq + pm * 256; u.gates = nullptr; u.ldc = nN * 256; u.mode = 1; return u;
    }
};
struct RU { int pm, pn; };
struct SchedR {
    typedef RU Unit;
    const char* A; const char* B; int K, G, c;
    __device__ __forceinline__ bool next(int i, AB& u) const {
        const int Lx = i * G + c; if (Lx >= 256) return false;
        u.A = A + (size_t)(Lx & 31) * 256 * K * 2; u.B = B + (size_t)(Lx >> 5) * 256 * K * 2; return true;
    }
    __device__ __forceinline__ RU full(int i) const { const int Lx = i * G + c; RU u; u.pm = Lx & 31; u.pn = Lx >> 5; return u; }
};
struct EpiR {
    static constexpr bool PERM = true;
    bf16_t* hb; u64* ssq; LAS float* red;
    __device__ __forceinline__ void operator()(const f32x4 (&acc)[2][2][4][2], const RU& u, int wr, int wc, int fr, int fq) const {
        const int col0 = u.pn * 256 + wc * 32 + 8 * fq, ln_ = fq * 16 + fr;
        u32x4 bb[2][4][2];
        float sqv[2][4];
#pragma unroll
        for (int ai = 0; ai < 2; ++ai)
#pragma unroll
            for (int m = 0; m < 4; ++m) { const bf16_t* rp = hb + (size_t)(u.pm * 256 + ai * 128 + wr * 64 + m * 16 + fr) * D_ + col0; bb[ai][m][0] = *(const u32x4*)rp; bb[ai][m][1] = *(const u32x4*)(rp + 128); }
#pragma unroll
        for (int ai = 0; ai < 2; ++ai)
#pragma unroll
            for (int m = 0; m < 4; ++m) {
                const int row = u.pm * 256 + ai * 128 + wr * 64 + m * 16 + fr; float sq = 0.f;
                bf16_t* rp = hb + (size_t)row * D_ + col0;
#pragma unroll
                for (int bj = 0; bj < 2; ++bj) {
                    const u32x4 b = bb[ai][m][bj];
                    const f32x4 v0 = acc[ai][bj][m][0] + (f32x4){bflo(b.x), bfhi(b.x), bflo(b.y), bfhi(b.y)};
                    const f32x4 v1 = acc[ai][bj][m][1] + (f32x4){bflo(b.z), bfhi(b.z), bflo(b.w), bfhi(b.w)};
                    u32x4 w; w.x = cvt_pk_bf16(v0[0], v0[1]); w.y = cvt_pk_bf16(v0[2], v0[3]); w.z = cvt_pk_bf16(v1[0], v1[1]); w.w = cvt_pk_bf16(v1[2], v1[3]);
                    *(u32x4*)(rp + bj * 128) = w;
                    sq += ((v0[0] * v0[0] + v0[1] * v0[1]) + (v0[2] * v0[2] + v0[3] * v0[3])) + ((v1[0] * v1[0] + v1[1] * v1[1]) + (v1[2] * v1[2] + v1[3] * v1[3]));
                }
                sqv[ai][m] = sq;
            }
#pragma unroll
        for (int ai = 0; ai < 2; ++ai)
#pragma unroll
            for (int m = 0; m < 4; ++m) sqv[ai][m] += shx(sqv[ai][m], 16, ln_);
#pragma unroll
        for (int ai = 0; ai < 2; ++ai)
#pragma unroll
            for (int m = 0; m < 4; ++m) { const float t = xsum(sqv[ai][m]); if (fq == 0) red[wc * 256 + ai * 128 + wr * 64 + m * 16 + fr] = t; }
        asm volatile("s_waitcnt lgkmcnt(0)" ::: "memory"); __builtin_amdgcn_s_barrier(); asm volatile("" ::: "memory");
        { const int t_ = (wr * 4 + wc) * 64 + ln_;
          if (t_ < 256) atomicAdd(ssq + u.pm * 256 + t_, (u64)__float2ull_rn(((red[t_] + red[256 + t_]) + (red[512 + t_] + red[768 + t_])) * SSQ_SCALE)); }
    }
};


struct CU2 { int pm, pn; };
struct SchedUp {
    typedef CU2 Unit;
    unsigned char* ws; int l, G, c;
    __device__ __forceinline__ bool next(int i, AB& u) const {
        const int Lx = i * G + c; if (Lx >= 33 * 44) return false;
        int pm, pn; tile_order(Lx, 33, 44, pm, pn);
        u.A = (const char*)(ws + WS_HB) + ((long)pm * 254 - 2) * (D_ * 2); u.B = (const char*)(ws + WS_W + (size_t)l * SZ_LAYER + OF_WUP) + (size_t)pn * 256 * D_ * 2; return true;
    }
    __device__ __forceinline__ CU2 full(int i) const { const int Lx = i * G + c; CU2 u; tile_order(Lx, 33, 44, u.pm, u.pn); return u; }
};
__device__ __forceinline__ float dpp_ror1(float v) { return __int_as_float(__builtin_amdgcn_mov_dpp(__float_as_int(v), 0x121, 0xF, 0xF, true)); }
__device__ __forceinline__ float dpp_ror2(float v) { return __int_as_float(__builtin_amdgcn_mov_dpp(__float_as_int(v), 0x122, 0xF, 0xF, true)); }
struct EpiC {
    static constexpr bool PERM = true;
    const Params& p; unsigned char* ws; int l; LAS float* hal;
    __device__ __forceinline__ void operator()(const f32x4 (&acc)[2][2][4][2], const CU2& u, int wr, int wc, int fr_, int fq_) const {
        int ln0 = (int)__builtin_amdgcn_mbcnt_hi(~0u, __builtin_amdgcn_mbcnt_lo(~0u, 0u)); asm volatile("" : "+v"(ln0)); const int fr = ln0 & 15, fq = ln0 >> 4;
        int cl = 32 * wc + 8 * fq, rb = 128 * wr + 8 * fr; asm volatile("" : "+v"(cl), "+v"(rb));
        const int t0 = 254 * u.pm - 2, tb = t0 + rb;
        const u64* ssq = (const u64*)(ws + WS_SSQ) + (3 * l + 2) * T_; const float* cw = p.conv_w + (size_t)l * 3 * 2 * FF_; const float* cb = p.conv_b + (size_t)l * 2 * FF_; bf16_t* act = (bf16_t*)(ws + WS_ACT);
        float rsv[8];
        { u64 q_[8];
#pragma unroll
          for (int j = 0; j < 8; ++j) q_[j] = ssq[(unsigned)(tb + j) < (unsigned)T_ ? tb + j : 0];
#pragma unroll
          for (int j = 0; j < 8; ++j) rsv[j] = (unsigned)(tb + j) < (unsigned)T_ ? rsqrtf(u64f(q_[j]) * SSQ_INV + EPS) : 0.f; }
        if (wr == 0 && fr == 15) {
#pragma unroll
            for (int bj = 0; bj < 2; ++bj)
#pragma unroll
                for (int n = 0; n < 2; ++n) { *(LAS f32x4*)(hal + 128 * bj + cl + 4 * n) = acc[1][bj][2][n] * rsv[6]; *(LAS f32x4*)(hal + 256 + 128 * bj + cl + 4 * n) = acc[1][bj][3][n] * rsv[7]; }
        }
        asm volatile("s_waitcnt lgkmcnt(0)" ::: "memory"); __builtin_amdgcn_s_barrier(); asm volatile("" ::: "memory");
#pragma unroll
        for (int n = 0; n < 2; ++n) {
            const float* wp = cw + 128 * u.pn + cl + 4 * n; const float* bp = cb + 128 * u.pn + cl + 4 * n;
            const f32x4 g0 = *(const f32x4*)wp, g1 = *(const f32x4*)(wp + 2 * FF_), g2 = *(const f32x4*)(wp + 4 * FF_), gb = *(const f32x4*)bp;
            const f32x4 v0 = *(const f32x4*)(wp + FF_), v1 = *(const f32x4*)(wp + 3 * FF_), v2 = *(const f32x4*)(wp + 5 * FF_), vb = *(const f32x4*)(bp + FF_);
            f32x4 pg2 = acc[1][0][2][n] * rsv[6], pg1 = acc[1][0][3][n] * rsv[7], pv2 = acc[1][1][2][n] * rsv[6], pv1 = acc[1][1][3][n] * rsv[7];
#pragma unroll
            for (int e = 0; e < 4; ++e) {
                pg2[e] = __int_as_float(__builtin_amdgcn_mov_dpp(__float_as_int(pg2[e]), 0x111, 0xF, 0xF, true)); pg1[e] = __int_as_float(__builtin_amdgcn_mov_dpp(__float_as_int(pg1[e]), 0x111, 0xF, 0xF, true));
                pv2[e] = __int_as_float(__builtin_amdgcn_mov_dpp(__float_as_int(pv2[e]), 0x111, 0xF, 0xF, true)); pv1[e] = __int_as_float(__builtin_amdgcn_mov_dpp(__float_as_int(pv1[e]), 0x111, 0xF, 0xF, true));
            }
            if (fr == 0 && wr == 1) { pg2 = *(const LAS f32x4*)(hal + cl + 4 * n); pg1 = *(const LAS f32x4*)(hal + 256 + cl + 4 * n); pv2 = *(const LAS f32x4*)(hal + 128 + cl + 4 * n); pv1 = *(const LAS f32x4*)(hal + 384 + cl + 4 * n); }
#pragma unroll
            for (int j = 0; j < 8; ++j) {
                const f32x4 xg = acc[j >> 2][0][j & 3][n] * rsv[j], xv = acc[j >> 2][1][j & 3][n] * rsv[j];
                const f32x4 gc = gb + g2 * xg + g1 * pg1 + g0 * pg2, vc = vb + v2 * xv + v1 * pv1 + v0 * pv2;
                f32x4 sg;
#pragma unroll
                for (int e = 0; e < 4; ++e) sg[e] = __builtin_amdgcn_rcpf(1.f + __expf(-gc[e]));
                const f32x4 o4 = gc * sg * vc;
                pg2 = pg1; pg1 = xg; pv2 = pv1; pv1 = xv;
                if (rb + j >= 2 && tb + j < T_) { u32x2 w; w.x = cvt_pk_bf16(o4[0], o4[1]); w.y = cvt_pk_bf16(o4[2], o4[3]); *(u32x2*)(act + (size_t)(tb + j) * FF_ + 128 * u.pn + cl + 4 * n) = w; }
                __builtin_amdgcn_sched_barrier(0);
            }
        }
    }
};

constexpr int AT_KROW = 272, AT_VROW = 144, AT_KBUF = 64 * AT_KROW, AT_VBUF = 128 * AT_VROW, AT_BUF = AT_KBUF + AT_VBUF + 256;
constexpr int AT_T5 = 73728;
template <int MODE>
__device__ __forceinline__ void attn_unit(LAS unsigned char* lds, const int tid_in, const bf16_t* Qrow, const bf16_t* Kb, int kpitch, const bf16_t* VTb, int vpitch, int kt0, int kt1,
                                          int t_row, int tq0, const float* cb, float m_init, float l_init, const LAS float* t5, bf16_t* Orow, float kn = 0.f) {
    int tid = tid_in; asm volatile("" : "+v"(tid));
    const int lane = tid & 63, r = lane & 31, hh = lane >> 5;
    constexpr float SC = 0.08838834764831845f * LOG2E;
    bf16x8 qf[8];
#pragma unroll
    for (int ks = 0; ks < 8; ++ks) qf[ks] = *(const bf16x8*)(Qrow + 16 * ks + 8 * hh);
    f32x16 o[4];
#pragma unroll
    for (int db = 0; db < 4; ++db)
#pragma unroll
        for (int i = 0; i < 16; ++i) o[db][i] = 0.f;
    float m = m_init, l = (hh == 0) ? l_init : 0.f;
    const int pr = (r & ~12) | ((r & 4) << 1) | ((r & 8) >> 1);
    const unsigned koff = pr * AT_KROW + 16 * hh, voff = AT_KBUF + r * AT_VROW + 16 * hh;
    const int kkey0 = tid >> 4, kc16 = tid & 15, vd0 = tid >> 3, vc8 = tid & 7;
    u32x4 kreg[2], vreg[2]; float creg = 0.f;
#define AT_LOAD(kt) do { const int k0_ = (kt) * 64; \
        kreg[0] = *(const u32x4*)(Kb + (size_t)(k0_ + kkey0) * kpitch + kc16 * 8); kreg[1] = *(const u32x4*)(Kb + (size_t)(k0_ + kkey0 + 32) * kpitch + kc16 * 8); \
        vreg[0] = *(const u32x4*)(VTb + (size_t)vd0 * vpitch + k0_ + vc8 * 8); vreg[1] = *(const u32x4*)(VTb + (size_t)(vd0 + 64) * vpitch + k0_ + vc8 * 8); \
        if (MODE == 0 && tid < 64) creg = cb[k0_ + tid]; } while (0)
#define AT_WRITE(b) do { LAS unsigned char* base_ = lds + (b) * AT_BUF; \
        *(LAS u32x4*)(base_ + kkey0 * AT_KROW + kc16 * 16) = kreg[0]; *(LAS u32x4*)(base_ + (kkey0 + 32) * AT_KROW + kc16 * 16) = kreg[1]; \
        *(LAS u32x4*)(base_ + AT_KBUF + vd0 * AT_VROW + vc8 * 16) = vreg[0]; *(LAS u32x4*)(base_ + AT_KBUF + (vd0 + 64) * AT_VROW + vc8 * 16) = vreg[1]; \
        if (MODE == 0 && tid < 64) *(LAS float*)(base_ + AT_KBUF + AT_VBUF + tid * 4) = -creg * LOG2E; } while (0)
    float qn = 0.f; bool wdone = false;
    LAS unsigned* flg = (LAS unsigned*)(lds + 2 * AT_BUF);
    if (MODE == 0) {
#pragma unroll
        for (int ks = 0; ks < 8; ++ks) { const u32x4 qq = __builtin_bit_cast(u32x4, qf[ks]);
            qn += bflo(qq.x) * bflo(qq.x) + bfhi(qq.x) * bfhi(qq.x) + bflo(qq.y) * bflo(qq.y) + bfhi(qq.y) * bfhi(qq.y) + bflo(qq.z) * bflo(qq.z) + bfhi(qq.z) * bfhi(qq.z) + bflo(qq.w) * bflo(qq.w) + bfhi(qq.w) * bfhi(qq.w); }
        qn = xsum(qn); qn = sqrtf(qn) * kn * SC * 1.0001f + 1e-3f;
    }
    AT_LOAD(kt1 - 1); AT_WRITE(0); __syncthreads();
#pragma unroll 1
    for (int kt = kt1 - 1; kt >= kt0; --kt) {
        const int cur = (kt1 - 1 - kt) & 1, k0 = kt * 64;
        if (kt > kt0) AT_LOAD(kt - 1);
        bool active = true;
        if (MODE == 0) active = (k0 <= tq0 + 31) && !wdone;
        if (MODE == 1) active = (k0 <= tq0 + 31) && (k0 + 63 > tq0 - 128);
        if (active) {
            const LAS unsigned char* base = lds + cur * AT_BUF;
            f32x16 s0, s1;
#pragma unroll
            for (int i = 0; i < 16; ++i) { s0[i] = 0.f; s1[i] = 0.f; }
            {
                bf16x8 ka[8];
#pragma unroll
                for (int ks = 0; ks < 8; ++ks) ka[ks] = *(const LAS bf16x8*)(base + koff + ks * 32);
                __builtin_amdgcn_sched_barrier(0);
#pragma unroll
                for (int ks = 0; ks < 8; ++ks) s0 = MFMA32(ka[ks], qf[ks], s0);
                __builtin_amdgcn_sched_barrier(0);
#pragma unroll
                for (int ks = 0; ks < 8; ++ks) ka[ks] = *(const LAS bf16x8*)(base + 32 * AT_KROW + koff + ks * 32);
                __builtin_amdgcn_sched_barrier(0);
#pragma unroll
                for (int ks = 0; ks < 8; ++ks) s1 = MFMA32(ka[ks], qf[ks], s1);
            }
            float x[32];
            const LAS float* cbl = (const LAS float*)(base + AT_KBUF + AT_VBUF);
            const bool need_mask = (MODE == 0) ? (k0 + 63 > tq0) : true;
            float mx = NEG;
            if (MODE == 1) {
#pragma unroll
                for (int i = 0; i < 32; ++i) { const int ii = i & 15, kl = 32 * (i >> 4) + (ii & 7) + 8 * hh + 16 * (ii >> 3); x[i] = t5[(t_row - (k0 + kl)) & 127]; }
                __builtin_amdgcn_sched_barrier(0);
            }
#pragma unroll
            for (int i = 0; i < 32; ++i) {
                const int blk = i >> 4, ii = i & 15, kl = 32 * blk + (ii & 7) + 8 * hh + 16 * (ii >> 3);
                float v = (blk ? s1[ii] : s0[ii]) * SC;
                if (MODE == 0) v += cbl[kl];
                if (MODE == 1) { const int rel = t_row - (k0 + kl); v = ((unsigned)rel < 128u) ? v + x[i] : NEG; }
                x[i] = v;
            }
            if (MODE == 0 && need_mask) {
#pragma unroll
                for (int i = 0; i < 32; ++i) { const int ii = i & 15, kl = 32 * (i >> 4) + (ii & 7) + 8 * hh + 16 * (ii >> 3); if (k0 + kl > t_row) x[i] = NEG; }
            }
#pragma unroll
            for (int i = 0; i < 32; ++i) mx = fmaxf(mx, x[i]);
            mx = xmax(mx);
            const float mn = fmaxf(m, mx), alpha = ex2(m - mn); m = mn;
            float rs = 0.f;
#pragma unroll
            for (int i = 0; i < 32; ++i) { x[i] = ex2(x[i] - mn); rs += x[i]; }
            l = l * alpha + rs;
#pragma unroll
            for (int db = 0; db < 4; ++db)
#pragma unroll
                for (int i = 0; i < 16; ++i) o[db][i] *= alpha;
            bf16x8 pf[4];
#pragma unroll
            for (int j = 0; j < 4; ++j) pf[j] = pack8(x[8 * j], x[8 * j + 1], x[8 * j + 2], x[8 * j + 3], x[8 * j + 4], x[8 * j + 5], x[8 * j + 6], x[8 * j + 7]);
#pragma unroll
            for (int jh = 0; jh < 2; ++jh) {
                bf16x8 va[2][4];
#pragma unroll
                for (int j = 0; j < 2; ++j)
#pragma unroll
                    for (int db = 0; db < 4; ++db) va[j][db] = *(const LAS bf16x8*)(base + voff + db * 32 * AT_VROW + (2 * jh + j) * 32);
                __builtin_amdgcn_sched_barrier(0);
#pragma unroll
                for (int j = 0; j < 2; ++j)
#pragma unroll
                    for (int db = 0; db < 4; ++db) o[db] = MFMA32(va[j][db], pf[2 * jh + j], o[db]);
                __builtin_amdgcn_sched_barrier(0);
            }
            if (MODE == 0 && kt > kt0 && k0 <= tq0) {
                const float ub = qn + cbl[0];
                wdone = __all(ub < m - 30.f);
            }
        }
        if (kt > kt0) AT_WRITE(cur ^ 1);
        if (MODE == 0) { if (lane == 0) flg[cur * 8 + (tid >> 6)] = wdone ? 0u : 1u; }
        __syncthreads();
        if (MODE == 0) { const u32x4 f0 = *(const LAS u32x4*)(flg + cur * 8), f1 = *(const LAS u32x4*)(flg + cur * 8 + 4);
            if (((f0.x | f0.y) | (f0.z | f0.w) | (f1.x | f1.y) | (f1.z | f1.w)) == 0u) break; }
    }
    if (MODE == 0) __syncthreads();
#undef AT_LOAD
#undef AT_WRITE
    l = xsum(l);
    const float inv = 1.f / l;
#pragma unroll
    for (int db = 0; db < 4; ++db)
#pragma unroll
        for (int g = 0; g < 4; g += 2) {
            unsigned ax = cvt_pk_bf16(o[db][4 * g] * inv, o[db][4 * g + 1] * inv), ay = cvt_pk_bf16(o[db][4 * g + 2] * inv, o[db][4 * g + 3] * inv);
            unsigned bx = cvt_pk_bf16(o[db][4 * g + 4] * inv, o[db][4 * g + 5] * inv), by = cvt_pk_bf16(o[db][4 * g + 6] * inv, o[db][4 * g + 7] * inv);
            const auto rx = __builtin_amdgcn_permlane32_swap(ax, bx, false, false), ry = __builtin_amdgcn_permlane32_swap(ay, by, false, false);
            u32x4 w; w.x = rx[0]; w.y = ry[0]; w.z = rx[1]; w.w = ry[1];
            *(u32x4*)(Orow + 32 * db + 8 * g + 8 * hh) = w;
        }
}

template <int MODEC>
__device__ __forceinline__ void gla_unit(LAS unsigned char* lds, const int tid_in, const Params& p, int l, int hh, int n) {
    int tid = tid_in; asm volatile("" : "+v"(tid));
    const int lane = tid & 63, w = __builtin_amdgcn_readfirstlane(tid >> 6), r = lane & 31, h2 = lane >> 5;
    unsigned char* ws = p.ws; asm volatile("" : "+s"(ws));
    const float* gates = (const float*)(ws + WS_GATES); const bf16_t* proj = (const bf16_t*)(ws + WS_PROJ); const bf16_t* vT = (const bf16_t*)(ws + WS_VT);
    float* kvb = (float*)(ws + WS_KVB); float* dec = (float*)(ws + WS_DEC);
    LAS float* bmat = (LAS float*)lds; LAS float* seg = (LAS float*)(lds + 16384); LAS float* blast = (LAS float*)(lds + 18432);
    LAS bf16_t* QT = (LAS bf16_t*)(lds + 18688); LAS bf16_t* KT = (LAS bf16_t*)(lds + 27904); LAS float* ss = (LAS float*)(lds + 37120);
    const int t0 = 64 * n;
    {
        const int d = lane; const float* wg = p.w_gla_gate + (size_t)l * 16 * 256 + hh * 64 + d; const float bgv = p.b_gla_gate[l * 256 + hh * 64 + d];
        float wgr[16];
#pragma unroll
        for (int q = 0; q < 16; ++q) wgr[q] = wg[q * 256];
        LAS float* gl = (LAS float*)(lds + 38400);
        if (tid < 256) *(LAS f32x4*)(gl + (tid >> 2) * 16 + (tid & 3) * 4) = *(const f32x4*)(gates + (size_t)(t0 + (tid >> 2)) * 32 + 4 + (tid & 3) * 4);
        __syncthreads();
        float pcs[8]; float run = 0.f;
#pragma unroll
        for (int j = 0; j < 8; ++j) { const LAS float* gp = gl + (w * 8 + j) * 16; float z = bgv;
#pragma unroll
            for (int q = 0; q < 16; ++q) z += gp[q] * wgr[q];
            run += logsig(z) * (1.f / 16.f); pcs[j] = run; }
        seg[w * 64 + d] = run; __syncthreads();
        float off = 0.f, tot = 0.f;
#pragma unroll
        for (int g = 0; g < 8; ++g) { const float sv = seg[g * 64 + d]; tot += sv; if (g < w) off += sv; }
#pragma unroll
        for (int j = 0; j < 8; ++j) bmat[(w * 8 + j) * 64 + d] = off + pcs[j];
        if (w == 0) blast[d] = tot;
        __syncthreads();
    }
    const int s = tid >> 3, dk8 = (tid & 7) * 8;
    if (MODEC == 0) {
        const u32x4 kk = *(const u32x4*)(proj + (size_t)(t0 + s) * NP + PJ_GK + hh * 64 + dk8);
        const unsigned kw[4] = {kk.x, kk.y, kk.z, kk.w};
#pragma unroll
        for (int j = 0; j < 8; ++j) { const float kf = ((j & 1) ? bfhi(kw[j >> 1]) : bflo(kw[j >> 1])) * __expf(blast[dk8 + j] - bmat[s * 64 + dk8 + j]);
            QT[(dk8 + j) * 72 + s] = (bf16_t)(cvt_pk_bf16(kf, 0.f) & 0xffffu); }
        if (tid < 64) dec[(size_t)(hh * 128 + n) * 64 + tid] = __expf(blast[tid]);
        __syncthreads();
        const int dvb = w & 3, dkb = w >> 2;
        f32x16 acc;
#pragma unroll
        for (int i = 0; i < 16; ++i) acc[i] = 0.f;
        bf16x8 va[4];
#pragma unroll
        for (int ks = 0; ks < 4; ++ks) va[ks] = *(const bf16x8*)(vT + (size_t)(VT_G + hh * 128 + 32 * dvb + r) * T_ + t0 + 16 * ks + 8 * h2);
#pragma unroll
        for (int ks = 0; ks < 4; ++ks) {
            const bf16x8 b = *(const LAS bf16x8*)(QT + (32 * dkb + r) * 72 + 16 * ks + 8 * h2);
            acc = MFMA32(va[ks], b, acc);
        }
        float* kp = kvb + (size_t)(hh * 128 + n) * 128 * 64 + 32 * dkb + r;
#pragma unroll
        for (int i = 0; i < 16; ++i) { const int dv = 32 * dvb + (i & 3) + 8 * (i >> 2) + 4 * h2; kp[(size_t)dv * 64] = acc[i]; }
        __syncthreads();
    } else {
        const u32x4 qq = *(const u32x4*)(proj + (size_t)(t0 + s) * NP + PJ_GQ + hh * 64 + dk8);
        const u32x4 kk = *(const u32x4*)(proj + (size_t)(t0 + s) * NP + PJ_GK + hh * 64 + dk8);
        const unsigned qw[4] = {qq.x, qq.y, qq.z, qq.w}, kw[4] = {kk.x, kk.y, kk.z, kk.w};
        float qv[8], kv[8];
#pragma unroll
        for (int j = 0; j < 8; ++j) { const float b = bmat[s * 64 + dk8 + j];
            qv[j] = ((j & 1) ? bfhi(qw[j >> 1]) : bflo(qw[j >> 1])) * 0.125f * __expf(b);
            kv[j] = ((j & 1) ? bfhi(kw[j >> 1]) : bflo(kw[j >> 1])) * __expf(-b); }
        *(LAS bf16x8*)(QT + s * 72 + dk8) = pack8(qv[0], qv[1], qv[2], qv[3], qv[4], qv[5], qv[6], qv[7]);
        *(LAS bf16x8*)(KT + s * 72 + dk8) = pack8(kv[0], kv[1], kv[2], kv[3], kv[4], kv[5], kv[6], kv[7]);
        __syncthreads();
        const int dvb = w & 3, tb = w >> 2, tt = 32 * tb + r;
        const int pr = (r & ~12) | ((r & 4) << 1) | ((r & 8) >> 1);
        bf16x8 qfr[4];
#pragma unroll
        for (int ks = 0; ks < 4; ++ks) qfr[ks] = *(const LAS bf16x8*)(QT + tt * 72 + 16 * ks + 8 * h2);
        f32x16 acc;
#pragma unroll
        for (int i = 0; i < 16; ++i) acc[i] = 0.f;
        bf16x8 vfr[2][2]; f32x4 sfr[4][2];
#pragma unroll
        for (int sb = 0; sb < 2; ++sb)
#pragma unroll
            for (int kk2 = 0; kk2 < 2; ++kk2) vfr[sb][kk2] = *(const bf16x8*)(vT + (size_t)(VT_G + hh * 128 + 32 * dvb + r) * T_ + t0 + 32 * sb + 16 * kk2 + 8 * h2);
        { const float* sp_ = kvb + ((size_t)(hh * 128 + n) * 128 + 32 * dvb + r) * 64 + 8 * h2;
#pragma unroll
          for (int ks = 0; ks < 4; ++ks) { sfr[ks][0] = *(const f32x4*)(sp_ + 16 * ks); sfr[ks][1] = *(const f32x4*)(sp_ + 16 * ks + 4); } }
#pragma unroll
        for (int sb = 0; sb < 2; ++sb) {
            if (sb <= tb) {
                f32x16 sa;
#pragma unroll
                for (int i = 0; i < 16; ++i) sa[i] = 0.f;
#pragma unroll
                for (int ks = 0; ks < 4; ++ks) { const bf16x8 a = *(const LAS bf16x8*)(KT + (32 * sb + pr) * 72 + 16 * ks + 8 * h2); sa = MFMA32(a, qfr[ks], sa); }
#pragma unroll
                for (int i = 0; i < 16; ++i) { const int sl = 32 * sb + (i & 7) + 8 * h2 + 16 * (i >> 3); if (sl > tt) sa[i] = 0.f; }
#pragma unroll
                for (int kk2 = 0; kk2 < 2; ++kk2) {
                    const bf16x8 pfr = pack8(sa[8 * kk2], sa[8 * kk2 + 1], sa[8 * kk2 + 2], sa[8 * kk2 + 3], sa[8 * kk2 + 4], sa[8 * kk2 + 5], sa[8 * kk2 + 6], sa[8 * kk2 + 7]);
                    acc = MFMA32(vfr[sb][kk2], pfr, acc);
                }
            }
        }
#pragma unroll
        for (int ks = 0; ks < 4; ++ks) {
            const f32x4 s0 = sfr[ks][0], s1 = sfr[ks][1];
            const bf16x8 a = pack8(s0[0], s0[1], s0[2], s0[3], s1[0], s1[1], s1[2], s1[3]);
            acc = MFMA32(a, qfr[ks], acc);
        }
        u32x2 gwv[4]; f32x4 gnq[4];
        { const bf16_t* grp_ = proj + (size_t)(t0 + tt) * NP + PJ_GR + hh * 128; const float* gn_ = p.gla_norm + l * 128;
#pragma unroll
          for (int g = 0; g < 4; ++g) { const int dv = 32 * dvb + 8 * g + 4 * h2; gwv[g] = *(const u32x2*)(grp_ + dv); gnq[g] = *(const f32x4*)(gn_ + dv); } }
        float part = 0.f;
#pragma unroll
        for (int i = 0; i < 16; ++i) part += acc[i] * acc[i];
        part += shx(part, 32, lane);
        if (h2 == 0) ss[tt * 4 + dvb] = part;
        __syncthreads();
        const float tot = (ss[tt * 4] + ss[tt * 4 + 1]) + (ss[tt * 4 + 2] + ss[tt * 4 + 3]);
        const float rstd = rsqrtf(tot * (1.f / 128.f) + EPS);
        bf16_t* op = (bf16_t*)(ws + WS_O) + (size_t)(t0 + tt) * D_ + 1536 + hh * 128;
        const bf16_t* grp = proj + (size_t)(t0 + tt) * NP + PJ_GR + hh * 128;
        const float* gn = p.gla_norm + l * 128;
#pragma unroll
        for (int g = 0; g < 4; ++g) {
            const int dv = 32 * dvb + 8 * g + 4 * h2;
            const u32x2 gw = gwv[g]; const f32x4 gnv = gnq[g];
            const float g0 = bflo(gw.x), g1 = bfhi(gw.x), g2 = bflo(gw.y), g3 = bfhi(gw.y);
            const float v0 = acc[4 * g] * rstd * gnv[0] * (g0 * __builtin_amdgcn_rcpf(1.f + __expf(-g0))), v1 = acc[4 * g + 1] * rstd * gnv[1] * (g1 * __builtin_amdgcn_rcpf(1.f + __expf(-g1)));
            const float v2 = acc[4 * g + 2] * rstd * gnv[2] * (g2 * __builtin_amdgcn_rcpf(1.f + __expf(-g2))), v3 = acc[4 * g + 3] * rstd * gnv[3] * (g3 * __builtin_amdgcn_rcpf(1.f + __expf(-g3)));
            u32x2 wv; wv.x = cvt_pk_bf16(v0, v1); wv.y = cvt_pk_bf16(v2, v3); *(u32x2*)(op + dv) = wv;
        }
        __syncthreads();
    }
}

__device__ __forceinline__ int inmap(int nd) {
    if (nd < 1024) return nd;
    if (nd < 2048) return 1540 + nd - 1024;
    if (nd < 2304) return 2564 + nd - 2048;
    if (nd < 2560) return 3076 + nd - 2304;
    if (nd < 2816) return 3332 + nd - 2560;
    if (nd < 3328) return 4100 + nd - 2816;
    if (nd < 3332) return 1536 + nd - 3328;
    if (nd < 3348) return 4612 + nd - 3332;
    if (nd < 3584) return -1;
    if (nd < 4096) return 1024 + nd - 3584;
    if (nd < 4352) return 2820 + nd - 4096;
    return 3588 + nd - 4352;
}
__device__ __forceinline__ int upmap(int nd) { const int pn = nd >> 8, q = nd & 255; return q < 128 ? 128 * pn + q : FF_ + 128 * pn + (q - 128); }
template <int MAPK>
__device__ __forceinline__ void transpose_item(const float* W, int K, int N, int ND, bf16_t* WT, const float* g, LAS float* scr, int item, int lane) {
    const int nblk = ND / 64, kb = item / nblk, nb = item % nblk, k0 = 64 * kb, n0 = 64 * nb;
    const int c4 = (lane & 15) * 4, kr = lane >> 4;
    int src = n0 + c4; if (MAPK == 1) src = inmap(src); if (MAPK == 2) src = upmap(src);
    f32x4 vv[16];
#pragma unroll
    for (int i = 0; i < 16; ++i) { const int kk = 4 * i + kr;
        vv[i] = (f32x4){0.f, 0.f, 0.f, 0.f};
        if (src >= 0) vv[i] = *(const f32x4*)(W + (size_t)(k0 + kk) * N + src); }
#pragma unroll
    for (int i = 0; i < 16; ++i) { const int kk = 4 * i + kr; f32x4 v = vv[i];
        if (g) v = v * g[k0 + kk];
        scr[kk * 65 + c4] = v[0]; scr[kk * 65 + c4 + 1] = v[1]; scr[kk * 65 + c4 + 2] = v[2]; scr[kk * 65 + c4 + 3] = v[3]; }
    asm volatile("s_waitcnt lgkmcnt(0)" ::: "memory");
    const int c = lane & 7;
#pragma unroll
    for (int j = 0; j < 8; ++j) { const int n = (lane >> 3) + 8 * j; const LAS float* sp = scr + (8 * c) * 65 + n;
        u32x4 o; o.x = cvt_pk_bf16(sp[0], sp[65]); o.y = cvt_pk_bf16(sp[2 * 65], sp[3 * 65]); o.z = cvt_pk_bf16(sp[4 * 65], sp[5 * 65]); o.w = cvt_pk_bf16(sp[6 * 65], sp[7 * 65]);
        *(u32x4*)(WT + (size_t)(n0 + n) * K + k0 + 8 * c) = o; }
    asm volatile("s_waitcnt lgkmcnt(0)" ::: "memory");
}
__device__ __forceinline__ float wave_sum(float v, int lane) {
#pragma unroll
    for (int o = 1; o < 64; o <<= 1) v += shx(v, o, lane);
    return v;
}


#define XB_TMO      128
#define XB_XCNT(j)  (256  + 64 * (j))
#define XB_XSUB(j)  (1280 + 64 * (j))
#define XB_XGEN(j)  (2304 + 64 * (j))
#define XB_TOP      3328
#define XB_TOPGEN   3392
#define XCD_BAR_WORDS 3456
#define XB_SPIN_CAP (1u << 22)
__device__ __forceinline__ unsigned xb_ld(unsigned* p)              { return __hip_atomic_load(p, __ATOMIC_RELAXED, __HIP_MEMORY_SCOPE_AGENT); }
__device__ __forceinline__ unsigned xb_add(unsigned* p, unsigned v) { return __hip_atomic_fetch_add(p, v, __ATOMIC_RELAXED, __HIP_MEMORY_SCOPE_AGENT); }
__device__ __forceinline__ unsigned xb_xcc_id() { return (unsigned)__builtin_amdgcn_s_getreg((3 << 11) | 20) & 0xFu; }
#define XB_SPIN(cond, bar) do { unsigned _sp = 0; while (cond) { __builtin_amdgcn_s_sleep(1); \
    if ((++_sp & 255u) == 0u) { if (xb_ld(&(bar)[XB_TMO])) break; if (_sp > XB_SPIN_CAP) { atomicAdd(&(bar)[XB_TMO], 1u); break; } } } } while (0)
__device__ __forceinline__ void xcd_barrier_complete(unsigned* bar, unsigned x, unsigned G, unsigned& nloc, unsigned& nx) {
    unsigned sum, cnt, mine, sp = 0u;
    for (;;) {
        sum = 0u; cnt = 0u; mine = 0u;
#pragma unroll
        for (unsigned j = 0; j < 16; ++j) { const unsigned cc = xb_ld(&bar[XB_XCNT(j)]); sum += cc; cnt += (cc > 0u) ? 1u : 0u; mine = (j == x) ? cc : mine; }
        if (sum == G) break;
        __builtin_amdgcn_s_sleep(1);
        if ((++sp & 255u) == 0u) { if (xb_ld(&bar[XB_TMO])) break; if (sp > XB_SPIN_CAP) { atomicAdd(&bar[XB_TMO], 1u); break; } }
    }
    nloc = mine > 0u ? mine : 1u; nx = cnt > 0u ? cnt : 1u;
}
__device__ __forceinline__ void xcd_barrier(unsigned* bar, volatile LAS unsigned* st, bool leader, unsigned G) {
    asm volatile("s_waitcnt vmcnt(0)" ::: "memory");
    __syncthreads();
    if (leader) {
        const unsigned x = xb_xcc_id();
        __builtin_amdgcn_s_waitcnt(0);
        unsigned nloc = st[0], nx = st[1];
        if (nloc == 0u) { xcd_barrier_complete(bar, x, G, nloc, nx); st[0] = nloc; st[1] = nx; }
        const unsigned old = xb_add(&bar[XB_XSUB(x)], 1u);
        const unsigned gen = old / nloc;
        if (old + 1u == (gen + 1u) * nloc) {
            __builtin_amdgcn_fence(__ATOMIC_RELEASE, "agent");
            asm volatile("s_waitcnt vmcnt(0)" ::: "memory");
            const unsigned og = xb_add(&bar[XB_TOP], 1u);
            const unsigned tg = og / nx;
            if (og + 1u == (tg + 1u) * nx) xb_add(&bar[XB_TOPGEN], 1u);
            else XB_SPIN(xb_ld(&bar[XB_TOPGEN]) == tg, bar);
            __builtin_amdgcn_fence(__ATOMIC_ACQUIRE, "agent");
            xb_add(&bar[XB_XGEN(x)], 1u);
            asm volatile("s_waitcnt vmcnt(0)" ::: "memory");
        } else {
            XB_SPIN(xb_ld(&bar[XB_XGEN(x)]) == gen, bar);
            __builtin_amdgcn_fence(__ATOMIC_ACQUIRE, "agent");
            asm volatile("s_waitcnt vmcnt(0)" ::: "memory");
        }
    }
    __syncthreads();
}

#ifndef PHM
#define PHM 0xFFFF
#endif
#define PH(k) ((PHM >> (k)) & 1)
#ifndef RPM
#define RPM 0
#endif
#define REPS(k) for (int rep_ = 0; rep_ < (((RPM) >> (k)) & 1) + 1; ++rep_)
#define WL (ws + WS_W + (size_t)l * SZ_LAYER)
__global__ void __launch_bounds__(512, 2) hybrid_fwd(Params p) {
    extern __shared__ __attribute__((aligned(16))) unsigned char lds_raw[];
    LAS unsigned char* lds = (LAS unsigned char*)lds_raw;
    cg::grid_group grid = cg::this_grid();
    const int G_blk = gridDim.x, c_blk = blockIdx.x;
    const int wave0 = __builtin_amdgcn_readfirstlane((int)threadIdx.x >> 6);
    if (threadIdx.x < 16) ((LAS unsigned*)(lds + LDS_BYTES - 64))[threadIdx.x] = 0u;
    __syncthreads();
#define PHB int c = c_blk, G = G_blk; asm volatile("" : "+s"(c), "+s"(G)); int tid = wave0 * 64 + (int)__builtin_amdgcn_mbcnt_hi(~0u, __builtin_amdgcn_mbcnt_lo(~0u, 0u)); asm volatile("" : "+v"(tid)); const int lane = tid & 63, wave = __builtin_amdgcn_readfirstlane(tid >> 6); unsigned char* ws = p.ws; asm volatile("" : "+s"(ws)); (void)lane; (void)wave;
#define ssq ((u64*)(ws + WS_SSQ))
#define H ((float*)(ws + WS_H))
#define HB ((bf16_t*)(ws + WS_HB))
#define PROJ ((bf16_t*)(ws + WS_PROJ))
#define GATES ((float*)(ws + WS_GATES))
#define VT ((bf16_t*)(ws + WS_VT))
#define O ((bf16_t*)(ws + WS_O))
#define QX ((bf16_t*)(ws + WS_QX))
#define XO ((bf16_t*)(ws + WS_XO))
#define KX ((bf16_t*)(ws + WS_KX))
#define VXT ((bf16_t*)(ws + WS_VXT))
#define MEMB ((bf16_t*)(ws + WS_MEMB))
#define U ((bf16_t*)(ws + WS_U))
#define ACT ((bf16_t*)(ws + WS_ACT))
#define KVB ((float*)(ws + WS_KVB))
#define DEC ((float*)(ws + WS_DEC))
#define CC ((float*)(ws + WS_C))
#define KNB ((unsigned*)(ws + WS_C + 512 * 1024))

    if (p.out == nullptr) grid.sync();
    if (wave0 == 0 && __builtin_amdgcn_mbcnt_hi(~0u, __builtin_amdgcn_mbcnt_lo(~0u, 0u)) == 0u) (void)xb_add((unsigned*)p.ws + XB_XCNT(xb_xcc_id()), 1u);
#define GSYNC do { const bool ldr_ = (wave0 == 0) && (__builtin_amdgcn_mbcnt_hi(~0u, __builtin_amdgcn_mbcnt_lo(~0u, 0u)) == 0u); \
        xcd_barrier((unsigned*)p.ws, (volatile LAS unsigned*)(lds + LDS_BYTES - 64), ldr_, (unsigned)G_blk); } while (0)


    if (PH(0)) REPS(0) { PHB
        LAS float* scr = (LAS float*)(lds + wave * 16640);
        const int gw = c * 8 + wave, NGW = G * 8;
        constexpr int I_IN = 32 * (NWIN / 64), I_OUT = 32 * 32, I_Q = 32 * 8, I_KV = 32 * 16, I_O = 8 * 32, I_UP = 32 * 176, I_DN = 88 * 32;
        constexpr int I_LAYER = I_IN + I_OUT + I_Q + I_KV + I_O + I_UP + I_DN;
        for (int it = gw; it < 4 * I_LAYER; it += NGW) {
            const int l = it / I_LAYER; int r = it % I_LAYER; unsigned char* wl = ws + WS_W + (size_t)l * SZ_LAYER;
            if (r < I_IN) { transpose_item<1>(p.w_in + (size_t)l * D_ * INC, D_, INC, NWIN, (bf16_t*)(WL + OF_WIN), p.norm_mix + l * D_, scr, r, lane); continue; } r -= I_IN;
            if (r < I_OUT) { transpose_item<0>(p.w_mix_out + (size_t)l * D_ * D_, D_, D_, D_, (bf16_t*)(WL + OF_WOUT), nullptr, scr, r, lane); continue; } r -= I_OUT;
            if (r < I_Q) { transpose_item<0>(p.wq_x + (size_t)l * D_ * 512, D_, 512, 512, (bf16_t*)(WL + OF_WQ), p.norm_xattn + l * D_, scr, r, lane); continue; } r -= I_Q;
            if (r < I_KV) { transpose_item<0>(p.wkv_x + (size_t)l * D_ * 1024, D_, 1024, 1024, (bf16_t*)(WL + OF_WKV), p.norm_mem + l * D_, scr, r, lane); continue; } r -= I_KV;
            if (r < I_O) { transpose_item<0>(p.wo_x + (size_t)l * 512 * D_, 512, D_, D_, (bf16_t*)(WL + OF_WO), nullptr, scr, r, lane); continue; } r -= I_O;
            if (r < I_UP) { transpose_item<2>(p.w_up + (size_t)l * D_ * 2 * FF_, D_, 2 * FF_, 2 * FF_, (bf16_t*)(WL + OF_WUP), p.norm_ffn + l * D_, scr, r, lane); continue; } r -= I_UP;
            transpose_item<0>(p.w_down + (size_t)l * FF_ * D_, FF_, D_, D_, (bf16_t*)(WL + OF_WDN), nullptr, scr, r, lane);
        }
        for (int mrow = gw; mrow < T_ + MEM_; mrow += NGW) {
            const bool ism = mrow >= T_; const float* src = ism ? p.mem + (size_t)(mrow - T_) * D_ : p.x + (size_t)mrow * D_;
            bf16_t* dst = ism ? MEMB + (size_t)(mrow - T_) * D_ : HB + (size_t)mrow * D_;
            f32x4 v[8]; float s = 0.f;
#pragma unroll
            for (int j = 0; j < 8; ++j) { v[j] = *(const f32x4*)(src + 256 * j + 4 * lane); s += (v[j][0] * v[j][0] + v[j][1] * v[j][1]) + (v[j][2] * v[j][2] + v[j][3] * v[j][3]); }
            s = wave_sum(s, lane);
            float sc = 1.f; if (ism) sc = rsqrtf(s * (1.f / D_) + EPS); else if (lane == 0) ssq[mrow] = (u64)__float2ull_rn(s * SSQ_SCALE);
#pragma unroll
            for (int j = 0; j < 8; ++j) { u32x2 w2; w2.x = cvt_pk_bf16(v[j][0] * sc, v[j][1] * sc); w2.y = cvt_pk_bf16(v[j][2] * sc, v[j][3] * sc); *(u32x2*)(dst + 256 * j + 4 * lane) = w2; }
        }
        for (int i = c * 512 + tid; i < 12 * T_; i += G * 512) ssq[T_ + i] = 0ull;
        if (c == 0 && tid < 16) KNB[tid] = 0u;
        if (c == 1) for (int i = tid; i < 2 * D_ / 2; i += 512) ((unsigned*)HB)[i - 2 * D_ / 2] = 0u;
    }
    GSYNC;
#pragma unroll 1
    for (int l = 0; l < L_; ++l) {
        if (PH(1)) REPS(1) { PHB
            SchedIn S{ws, l, (l == 0) ? 16 : 0, G, c};
            EpiB E;
            pg8::gemm_phase<EpiB, SchedIn>(lds, tid, D_, S, E);
        }
        GSYNC;
        if (PH(2)) REPS(2) { PHB
            for (int u = c; u < 4 + 512 + 64; u += G) {
                if (u < 4) {
                    const int hd = u; const float bf = p.b_fox_f[l * 4 + hd];
                    LAS float* wt = (LAS float*)lds;
                    float pre[16]; float run = 0.f;
#pragma unroll
                    for (int j = 0; j < 16; ++j) { run += logsig(GATES[(size_t)(tid * 16 + j) * 32 + hd] + bf); pre[j] = run; }
                    float xs = run;
#pragma unroll
                    for (int off = 1; off < 64; off <<= 1) { const float y = __int_as_float(__builtin_amdgcn_ds_bpermute((lane >= off ? lane - off : lane) << 2, __float_as_int(xs))); if (lane >= off) xs += y; }
                    if (lane == 63) wt[wave] = xs;
                    __syncthreads();
                    float base = 0.f;
#pragma unroll
                    for (int g = 0; g < 8; ++g) if (g < wave) base += wt[g];
                    const float excl = base + xs - run;
#pragma unroll
                    for (int j = 0; j < 16; ++j) CC[(size_t)hd * T_ + tid * 16 + j] = excl + pre[j];
                    __syncthreads();
                } else if (u < 516) {
                    const int v = u - 4; gla_unit<0>(lds, tid, p, l, v >> 7, v & 127);
                } else {
                    const int v = u - 516, hd = v >> 4, sl = v & 15; float mxn = 0.f;
#pragma unroll 4
                    for (int ps = 0; ps < 16; ++ps) {
                        const int key = sl * 512 + ps * 32 + (tid >> 4);
                        const u32x4 kk = *(const u32x4*)(PROJ + (size_t)key * NP + PJ_FK + hd * 128 + (tid & 15) * 8);
                        float q2 = bflo(kk.x) * bflo(kk.x) + bfhi(kk.x) * bfhi(kk.x) + bflo(kk.y) * bflo(kk.y) + bfhi(kk.y) * bfhi(kk.y) + bflo(kk.z) * bflo(kk.z) + bfhi(kk.z) * bfhi(kk.z) + bflo(kk.w) * bflo(kk.w) + bfhi(kk.w) * bfhi(kk.w);
                        q2 += shx(q2, 1, lane); q2 += shx(q2, 2, lane); q2 += shx(q2, 4, lane); q2 += shx(q2, 8, lane);
                        mxn = fmaxf(mxn, q2);
                    }
                    mxn = fmaxf(mxn, shx(mxn, 16, lane)); mxn = fmaxf(mxn, shx(mxn, 32, lane));
                    if (lane == 0) atomicMax(KNB + l * 4 + hd, __float_as_uint(mxn));
                }
            }
        }
        GSYNC;
        if (PH(3)) { PHB
            if (c < 128) {
                const int u = c;

                    const int qb = 31 - (u >> 2), hd = u & 3, tq0 = 256 * qb + 32 * wave, t_row = tq0 + (lane & 31);
                    attn_unit<0>(lds, tid, PROJ + (size_t)t_row * NP + PJ_FQ + hd * 128, PROJ + PJ_FK + hd * 128, NP, VT + (size_t)(VT_F + hd * 128) * T_, T_,
                                 0, 4 * (qb + 1), t_row, tq0, CC + (size_t)hd * T_, NEG, 0.f, nullptr, O + (size_t)t_row * D_ + hd * 128, sqrtf(__uint_as_float(KNB[l * 4 + hd])));
            } else {
                const int cc = c - 128;
                LAS float* t5 = (LAS float*)(lds + AT_T5);
            for (int i = tid; i < 1024; i += 512) { const int hd = i >> 7, n = i & 127;
                int bk = n; if (n >= 16) { bk = 16 + (int)(__logf((float)n / 16.f) / __logf(8.f) * 16.f); bk = bk < 31 ? bk : 31; }
                t5[i] = p.t5_bias[bk * 8 + hd] * LOG2E; }
            __syncthreads();
                if (cc < 64) {
                    const int u = cc + 128;
                    const int v = u - 128, hh = v >> 4, e = (v & 15) * 512 + tid, dk = tid & 63;
                    float* kp = KVB + (size_t)hh * 128 * 8192 + e; const float* dp = DEC + (size_t)hh * 128 * 64 + dk;
                    float S = 0.f;
                    for (int n0 = 0; n0 < 128; n0 += 32) {
                        float kvv[32], dd[32];
#pragma unroll
                        for (int j = 0; j < 32; ++j) { kvv[j] = kp[(size_t)(n0 + j) * 8192]; dd[j] = dp[(n0 + j) * 64]; }
#pragma unroll
                        for (int j = 0; j < 32; ++j) { kp[(size_t)(n0 + j) * 8192] = S; S = dd[j] * S + kvv[j]; }
                    }
                }
                for (int si = 0; si < (cc < 64 ? 1 : 3); ++si) {
                    const int su = cc < 64 ? cc : 64 + (cc - 64) * 3 + si;
                    const int v = su, kvh = v >> 7, n = (v >> 1) & 63, pr = v & 1;
                    const int hl = wave >> 2, qh = kvh * 4 + pr * 2 + hl, tq0 = 128 * n + 32 * (wave & 3), t_row = tq0 + (lane & 31);
                    attn_unit<1>(lds, tid, PROJ + (size_t)t_row * NP + PJ_SQ + qh * 128, PROJ + PJ_SK + kvh * 128, NP, VT + (size_t)(VT_S + kvh * 128) * T_, T_,
                                 (2 * n - 2) < 0 ? 0 : (2 * n - 2), 2 * n + 2, t_row, tq0, nullptr, p.swa_sinks[l * 8 + qh] * LOG2E, 1.f, t5 + qh * 128,
                                 O + (size_t)t_row * D_ + 512 + qh * 128);
                }
            }
        }
        GSYNC;
        if (PH(4)) REPS(4) { PHB for (int u = c; u < 512; u += G) gla_unit<1>(lds, tid, p, l, u >> 7, u & 127); }
        GSYNC;
        if (PH(5)) { PHB
            SchedR S{(const char*)O, (const char*)(WL + OF_WOUT), D_, G, c};
            EpiR E{HB, ssq + (3 * l + 1) * T_, (LAS float*)(lds + 131072)};
            pg8::gemm_phase<EpiR, SchedR>(lds, tid, D_, S, E);
        }
        GSYNC;
        if (PH(6)) REPS(6) { PHB
            SchedRow S{(const char*)HB, (const char*)(WL + OF_WQ), QX, ssq + (3 * l + 1) * T_, 32, 2, D_, G, c};
            EpiB E;
            pg8::gemm_phase<EpiB, SchedRow>(lds, tid, D_, S, E);
        }
        GSYNC;
        if (PH(7)) REPS(7) { PHB for (int u = c; u < 128; u += G) {
            const int hd = u & 3, qb = u >> 2, tq0 = 256 * qb + 32 * wave, t_row = tq0 + (lane & 31);
            attn_unit<2>(lds, tid, QX + (size_t)t_row * 512 + hd * 128, KX + (size_t)l * 256 * 512 + hd * 128, 512, VXT + (size_t)l * 512 * 256 + (size_t)hd * 128 * 256, 256,
                         0, 4, t_row, tq0, nullptr, NEG, 0.f, nullptr, XO + (size_t)t_row * 512 + hd * 128);
        } }
        GSYNC;
        if (PH(8)) { PHB
            SchedR S{(const char*)XO, (const char*)(WL + OF_WO), 512, G, c};
            EpiR E{HB, ssq + (3 * l + 2) * T_, (LAS float*)(lds + 131072)};
            pg8::gemm_phase<EpiR, SchedR>(lds, tid, 512, S, E);
        }
        GSYNC;
        if (PH(9)) REPS(9) { PHB
            SchedUp S{ws, l, G, c};
            EpiC E{p, ws, l, (LAS float*)(lds + 131072)};
            pg8::gemm_phase<EpiC, SchedUp, true>(lds, tid, D_, S, E);
        }
        GSYNC;
        if (PH(11)) { PHB
            SchedR S{(const char*)ACT, (const char*)(WL + OF_WDN), FF_, G, c};
            EpiR E{HB, ssq + (3 * l + 3) * T_, (LAS float*)(lds + 131072)};
            pg8::gemm_phase<EpiR, SchedR>(lds, tid, FF_, S, E);
        }
        GSYNC;
    }
    if (PH(12)) { PHB
        const u64* sq = ssq + 12 * T_;
        for (int row = c * 8 + wave; row < T_; row += G * 8) {
            const float rs = rsqrtf(u64f(sq[row]) * SSQ_INV + EPS);
#pragma unroll
            for (int j = 0; j < 8; ++j) { const u32x2 hv = *(const u32x2*)(HB + (size_t)row * D_ + 256 * j + 4 * lane); const f32x4 g = *(const f32x4*)(p.final_norm + 256 * j + 4 * lane);
                *(f32x4*)(p.out + (size_t)row * D_ + 256 * j + 4 * lane) = (f32x4){bflo(hv.x), bfhi(hv.x), bflo(hv.y), bfhi(hv.y)} * rs * g; }
        }
    }
}

extern "C" void kernel_launch(void* const* d_in, const int* in_sizes, int n_in, void* d_out, int out_size, void* d_ws, size_t ws_size, hipStream_t stream) {
    static int grid = 0;
    if (grid == 0) {
        if (n_in != 22 || ws_size < WS_END) { fprintf(stderr, "kernel_launch: unexpected n_in %d or ws_size %zu (< %zu)\n", n_in, ws_size, (size_t)WS_END); grid = -1; return; }
        int dev = 0, cus = 0, per_cu = 0;
        hipGetDevice(&dev); hipDeviceGetAttribute(&cus, hipDeviceAttributeMultiprocessorCount, dev);
        if (hipFuncSetAttribute((const void*)hybrid_fwd, hipFuncAttributeMaxDynamicSharedMemorySize, LDS_BYTES) != hipSuccess) { fprintf(stderr, "kernel_launch: hipFuncSetAttribute failed\n"); grid = -1; return; }
        hipOccupancyMaxActiveBlocksPerMultiprocessor(&per_cu, (const void*)hybrid_fwd, 512, LDS_BYTES);
        (void)hipGetLastError();
        if (per_cu < 1) { fprintf(stderr, "kernel_launch: occupancy query says %d\n", per_cu); per_cu = 1; }
        grid = cus * per_cu;
    }
    if (grid < 0) return;
    Params p{};
    const float** pp = (const float**)&p;
    for (int i = 0; i < 22; ++i) pp[i] = (const float*)d_in[i];
    p.out = (float*)d_out; p.ws = (unsigned char*)d_ws;
    if (hipMemsetAsync(d_ws, 0, 16384, stream) != hipSuccess) { fprintf(stderr, "kernel_launch: hipMemsetAsync of the barrier words failed\n"); return; }
    void* args[] = {&p};
    hipError_t e = hipLaunchCooperativeKernel((const void*)hybrid_fwd, dim3(grid), dim3(512), args, LDS_BYTES, stream);
    if (e != hipSuccess) fprintf(stderr, "cooperative launch failed: %s (grid %d)\n", hipGetErrorString(e), grid);
}
```

```cpp
#include <hip/hip_runtime.h>
#include <hip/hip_cooperative_groups.h>
#include <cstdio>
#include <cstdint>
namespace cg = cooperative_groups;

#define LAS __attribute__((address_space(3)))
typedef unsigned short bf16_t;
typedef short bf16x8 __attribute__((ext_vector_type(8)));
typedef float f32x4 __attribute__((ext_vector_type(4)));
typedef float f32x16 __attribute__((ext_vector_type(16)));
typedef unsigned u32x4 __attribute__((ext_vector_type(4)));
typedef unsigned u32x2 __attribute__((ext_vector_type(2)));

constexpr int T_ = 8192, D_ = 2048, L_ = 4, FF_ = 5632, INC = 4628, MEM_ = 256;
constexpr int NP = 3584;
constexpr int PJ_FQ = 0, PJ_FK = 512, PJ_SQ = 1024, PJ_SK = 2048, PJ_GQ = 2304, PJ_GK = 2560, PJ_GR = 2816, PJ_GT = 3328;
constexpr int VT_F = 0, VT_S = 512, VT_G = 768, NVT = 1280;
constexpr int NWIN = NP + NVT;
constexpr float EPS = 1e-6f, LOG2E = 1.4426950408889634f;
constexpr float NEG = -1e30f;

constexpr size_t MiB = 1ull << 20;
constexpr size_t SZ_WIN = (size_t)NWIN * D_ * 2, SZ_WOUT = (size_t)D_ * D_ * 2, SZ_WQ = 512ull * D_ * 2, SZ_WKV = 1024ull * D_ * 2,
                 SZ_WO = (size_t)D_ * 512 * 2, SZ_WUP = 2ull * FF_ * D_ * 2, SZ_WDN = (size_t)D_ * FF_ * 2;
constexpr size_t OF_WIN = 0, OF_WOUT = OF_WIN + SZ_WIN, OF_WQ = OF_WOUT + SZ_WOUT, OF_WKV = OF_WQ + SZ_WQ, OF_WO = OF_WKV + SZ_WKV,
                 OF_WUP = OF_WO + SZ_WO, OF_WDN = OF_WUP + SZ_WUP, SZ_LAYER = OF_WDN + SZ_WDN;
constexpr size_t WS_SSQ = 1 * MiB;
constexpr size_t WS_W = 2 * MiB;
constexpr size_t WS_H = WS_W + ((4 * SZ_LAYER + MiB - 1) / MiB) * MiB;
constexpr size_t WS_HB = WS_H + 64 * MiB;
constexpr size_t WS_PROJ = WS_HB + 32 * MiB;
constexpr size_t WS_GATES = WS_PROJ + 56 * MiB;
constexpr size_t WS_VT = WS_GATES + 1 * MiB;
constexpr size_t WS_O = WS_VT + 20 * MiB;
constexpr size_t WS_QX = WS_O + 32 * MiB;
constexpr size_t WS_XO = WS_QX + 8 * MiB;
constexpr size_t WS_KX = WS_XO + 8 * MiB;
constexpr size_t WS_VXT = WS_KX + 1 * MiB;
constexpr size_t WS_MEMB = WS_VXT + 1 * MiB;
constexpr size_t WS_U = WS_MEMB + 1 * MiB;
constexpr size_t WS_ACT = WS_U + 176 * MiB;
constexpr size_t WS_KVB = WS_ACT + 88 * MiB;
constexpr size_t WS_DEC = WS_KVB + 16 * MiB;
constexpr size_t WS_C = WS_DEC + 1 * MiB;
constexpr size_t WS_END = WS_C + 1 * MiB;

constexpr int LDS_BYTES = 147456;

struct Params {
    const float *x, *mem, *w_in, *b_fox_f, *swa_sinks, *t5_bias, *w_gla_gate, *b_gla_gate, *gla_norm, *w_mix_out, *norm_mix, *norm_xattn, *norm_mem,
        *wq_x, *wkv_x, *wo_x, *norm_ffn, *w_up, *conv_w, *conv_b, *w_down, *final_norm;
    float* out; unsigned char* ws;
};

__device__ __forceinline__ unsigned cvt_pk_bf16(float lo, float hi) { unsigned r; asm("v_cvt_pk_bf16_f32 %0, %1, %2" : "=v"(r) : "v"(lo), "v"(hi)); return r; }
__device__ __forceinline__ float bf2f(unsigned short b) { return __uint_as_float((unsigned)b << 16); }
__device__ __forceinline__ float bflo(unsigned w) { return __uint_as_float(w << 16); }
__device__ __forceinline__ float bfhi(unsigned w) { return __uint_as_float(w & 0xffff0000u); }
__device__ __forceinline__ float logsig(float x) { return fminf(x, 0.f) - __logf(1.f + __expf(-fabsf(x))); }
__device__ __forceinline__ float ex2(float x) { return __builtin_amdgcn_exp2f(x); }
__device__ __forceinline__ bf16x8 pack8(float a0, float a1, float a2, float a3, float a4, float a5, float a6, float a7) {
    u32x4 w; w.x = cvt_pk_bf16(a0, a1); w.y = cvt_pk_bf16(a2, a3); w.z = cvt_pk_bf16(a4, a5); w.w = cvt_pk_bf16(a6, a7);
    return __builtin_bit_cast(bf16x8, w);
}
__device__ __forceinline__ float shx(float v, int off, int lane) { return __int_as_float(__builtin_amdgcn_ds_bpermute((lane ^ off) << 2, __float_as_int(v))); }
__device__ __forceinline__ float xmax(float v) { const auto r = __builtin_amdgcn_permlane32_swap(__float_as_uint(v), __float_as_uint(v), false, false); return fmaxf(__uint_as_float(r[0]), __uint_as_float(r[1])); }
__device__ __forceinline__ float xsum(float v) { const auto r = __builtin_amdgcn_permlane32_swap(__float_as_uint(v), __float_as_uint(v), false, false); return __uint_as_float(r[0]) + __uint_as_float(r[1]); }
#define MFMA32(a, b, c) __builtin_amdgcn_mfma_f32_32x32x16_bf16((a), (b), (c), 0, 0, 0)

struct AB { const char* A; const char* B; };
namespace pg8 {
constexpr int BM = 256, BK = 64, HALF = 128, HTB = HALF * BK * 2, STAGE_BYTES = 8 * HTB;
__host__ __device__ __forceinline__ int lds_byte(int r, int c) { const int st = (r >> 4) * 2 + (c >> 5), rr = r & 15, cc = c & 31, ob = rr * 64 + cc * 2; return st * 1024 + (ob ^ (((ob >> 9) & 1) << 5)); }
__host__ __device__ __forceinline__ void stage_rc(int b, int& R, int& C) { const int st = b / 1024, sb = b % 1024, swz = sb ^ (((sb >> 9) & 1) << 5); R = (st >> 1) * 16 + swz / 64; C = (st & 1) * 32 + (swz % 64) / 2; }
__host__ __device__ __forceinline__ int perm32(int rho) { const int n = rho >> 4, i = rho & 15; return 8 * (i >> 2) + 4 * n + (i & 3); }

template <class Epi, class Sched, bool APERM = false, bool HALFN = false>
__device__ __forceinline__ void gemm_phase(LAS unsigned char* lds, const int tid_in, const int K, const Sched& S, const Epi& E) {
    typedef typename Sched::Unit Unit;
    int tid = tid_in; asm volatile("" : "+v"(tid));
    const int wid = __builtin_amdgcn_readfirstlane(tid >> 6), lane = tid & 63, wr = wid >> 2, wc = wid & 3, fr = lane & 15, fq = lane >> 4;
    const int nt = K / BK;
    unsigned voffA[2], voffB[2];
#pragma unroll
    for (int i = 0; i < 2; ++i) { int R, C; stage_rc(tid * 16 + i * 8192, R, C); const int Rb = Epi::PERM ? ((R & ~31) + perm32(R & 31)) : R;
        const int Ra = APERM ? (128 * (R >> 6) + 8 * (R & 15) + ((R >> 4) & 3)) : R;
        voffA[i] = (unsigned)(Ra * K + C) * 2u; voffB[i] = (unsigned)(Rb * K + C) * 2u; }
    const size_t kstep = (size_t)(BK * 2);
    const size_t hstep = (size_t)HALF * K * 2;
    const size_t hstepA = APERM ? (size_t)4 * K * 2 : hstep;
    const unsigned ldsw = (unsigned)wid * 1024u;
    const int aoff = lds_byte(wr * 64 + fr, fq * 8), boff = lds_byte(wc * 32 + fr, fq * 8);
#define PG8_SA(b, h) (((b) * 2 + (h)) * HTB)
#define PG8_SB(b, h) ((4 + (b) * 2 + (h)) * HTB)
#define PG8_STAGE(bufoff, gbase, voff) do { _Pragma("unroll") for (int _i = 0; _i < 2; ++_i) \
        __builtin_amdgcn_global_load_lds((const unsigned*)((const char*)(gbase) + (voff)[_i]), (LAS unsigned*)(lds + (bufoff) + ldsw + _i * 8192), 16, 0, 0); } while (0)
#define PG8_LDA(dst, b, h) do { _Pragma("unroll") for (int m = 0; m < 4; ++m) _Pragma("unroll") for (int k = 0; k < 2; ++k) dst[m][k] = *(const LAS bf16x8*)(lds + PG8_SA(b, h) + aoff + m * 2048 + k * 1024); } while (0)
#define PG8_LDB(dst, b, h) do { _Pragma("unroll") for (int n = 0; n < 2; ++n) _Pragma("unroll") for (int k = 0; k < 2; ++k) dst[n][k] = *(const LAS bf16x8*)(lds + PG8_SB(b, h) + boff + n * 2048 + k * 1024); } while (0)
#define PG8_MMA(ai, bj, At, Bt) do { __builtin_amdgcn_s_setprio(1); _Pragma("unroll") for (int m = 0; m < 4; ++m) _Pragma("unroll") for (int n = 0; n < 2; ++n) _Pragma("unroll") for (int k = 0; k < 2; ++k) \
        acc[ai][bj][m][n] = __builtin_amdgcn_mfma_f32_16x16x32_bf16(Bt[n][k], At[m][k], acc[ai][bj][m][n], 0, 0, 0); __builtin_amdgcn_s_setprio(0); } while (0)
#define PG8_WAIT_V(n) asm volatile("s_waitcnt vmcnt(" #n ")" ::: "memory")
#define PG8_WAIT_L(n) asm volatile("s_waitcnt lgkmcnt(" #n ")" ::: "memory")
#define PG8_BAR __builtin_amdgcn_s_barrier()
#define PG8_SCHED __builtin_amdgcn_sched_barrier(0)
    AB cur, nxt; int ui = 0;
    if (!S.next(0, cur)) return;
    f32x4 acc[2][2][4][2];
#pragma unroll
    for (int a = 0; a < 2; ++a)
#pragma unroll
        for (int b = 0; b < 2; ++b)
#pragma unroll
            for (int m = 0; m < 4; ++m)
#pragma unroll
                for (int n = 0; n < 2; ++n) acc[a][b][m][n] = (f32x4){0.f, 0.f, 0.f, 0.f};
    bf16x8 At[4][2], B0[2][2], B1[2][2];
    const char* cA = cur.A; const char* cB = cur.B;
    PG8_STAGE(PG8_SB(0, 0), cB, voffB); PG8_STAGE(PG8_SB(0, 1), cB + hstep, voffB); PG8_STAGE(PG8_SA(0, 0), cA, voffA); PG8_STAGE(PG8_SA(0, 1), cA + hstepA, voffA);
    if (wr == 1) PG8_BAR;
    PG8_WAIT_V(2); PG8_BAR;
    PG8_STAGE(PG8_SB(1, 0), cB + kstep, voffB); PG8_STAGE(PG8_SA(1, 0), cA + kstep, voffA); PG8_STAGE(PG8_SB(1, 1), cB + hstep + kstep, voffB);
    PG8_WAIT_V(6); PG8_BAR;
    for (;;) {
        const bool has_next = S.next(ui + 1, nxt);
        const char* nA = has_next ? nxt.A : cA; const char* nB = has_next ? nxt.B : cB;
        for (int t = 0; t < nt; t += 2) {
            const bool last = (t == nt - 2);
            const char* a1 = cA + (size_t)(t + 1) * kstep;
            const char* a2 = last ? nA : cA + (size_t)(t + 2) * kstep; const char* b2 = last ? nB : cB + (size_t)(t + 2) * kstep;
            const char* a3 = a2 + kstep; const char* b3 = b2 + kstep;
            PG8_LDB(B0, 0, 0); PG8_LDB(B1, 0, 1); PG8_SCHED; PG8_LDA(At, 0, 0); PG8_STAGE(PG8_SA(1, 1), a1 + hstepA, voffA);
            PG8_WAIT_V(8); PG8_WAIT_L(0); PG8_BAR; PG8_MMA(0, 0, At, B0); if constexpr (!HALFN) PG8_MMA(0, 1, At, B1); PG8_BAR; PG8_SCHED;
            PG8_LDA(At, 0, 1); PG8_STAGE(PG8_SB(0, 0), b2, voffB); PG8_STAGE(PG8_SB(0, 1), b2 + hstep, voffB); PG8_STAGE(PG8_SA(0, 0), a2, voffA);
            PG8_WAIT_V(8); PG8_WAIT_L(0); PG8_BAR; PG8_MMA(1, 0, At, B0); if constexpr (!HALFN) PG8_MMA(1, 1, At, B1); PG8_BAR; PG8_SCHED;
            PG8_LDB(B0, 1, 0); PG8_LDB(B1, 1, 1); PG8_SCHED; PG8_LDA(At, 1, 0); PG8_STAGE(PG8_SA(0, 1), a2 + hstepA, voffA);
            PG8_WAIT_V(8); PG8_WAIT_L(0); PG8_BAR; PG8_MMA(0, 0, At, B0); if constexpr (!HALFN) PG8_MMA(0, 1, At, B1); PG8_BAR; PG8_SCHED;
            PG8_LDA(At, 1, 1); PG8_STAGE(PG8_SB(1, 0), b3, voffB); PG8_STAGE(PG8_SB(1, 1), b3 + hstep, voffB); PG8_STAGE(PG8_SA(1, 0), a3, voffA);
            PG8_WAIT_V(8); PG8_WAIT_L(0); PG8_BAR; PG8_MMA(1, 0, At, B0); if constexpr (!HALFN) PG8_MMA(1, 1, At, B1); PG8_BAR; PG8_SCHED;
        }
        if (wr == 0) PG8_BAR;
        { const Unit fu = S.full(ui); E(acc, fu, wr, wc, fr, fq); }
        if (!has_next) break;
#pragma unroll
        for (int a = 0; a < 2; ++a)
#pragma unroll
            for (int b = 0; b < 2; ++b)
#pragma unroll
                for (int m = 0; m < 4; ++m)
#pragma unroll
                    for (int n = 0; n < 2; ++n) acc[a][b][m][n] = (f32x4){0.f, 0.f, 0.f, 0.f};
        cur = nxt; cA = nA; cB = nB; ++ui;
        if (wr == 1) PG8_BAR;
    }
    PG8_WAIT_V(0);
    PG8_BAR;
#undef PG8_SA
#undef PG8_SB
#undef PG8_STAGE
#undef PG8_LDA
#undef PG8_LDB
#undef PG8_MMA
#undef PG8_WAIT_V
#undef PG8_WAIT_L
#undef PG8_BAR
#undef PG8_SCHED
}
}

typedef unsigned long long u64;
constexpr float SSQ_SCALE = 16777216.f, SSQ_INV = 1.f / (16777216.f * 2048.f);
__device__ __forceinline__ float u64f(u64 q) { return (float)(unsigned)(q >> 32) * 4294967296.f + (float)(unsigned)q; }
struct GU { bf16_t* out; const u64* sc; float* gates; int ldc; int mode; };

struct EpiB {
    static constexpr bool PERM = true;
    __device__ __forceinline__ void operator()(const f32x4 (&acc)[2][2][4][2], const GU& u, int wr, int wc, int fr, int fq) const {
        const int r0 = wr * 64 + fr, c0 = wc * 32 + 8 * fq;
        f32x4 cs[2][2];
#pragma unroll
        for (int bj = 0; bj < 2; ++bj)
#pragma unroll
            for (int n = 0; n < 2; ++n) {
                if ((u.mode & 3) == 2) { const u64* q = u.sc + c0 + bj * 128 + 4 * n;
                    cs[bj][n] = (f32x4){rsqrtf(u64f(q[0]) * SSQ_INV + EPS), rsqrtf(u64f(q[1]) * SSQ_INV + EPS), rsqrtf(u64f(q[2]) * SSQ_INV + EPS), rsqrtf(u64f(q[3]) * SSQ_INV + EPS)}; }
                else cs[bj][n] = (f32x4){1.f, 1.f, 1.f, 1.f};
            }
        float rsv[2][4];
        if ((u.mode & 3) == 1) { u64 q_[2][4];
#pragma unroll
            for (int ai = 0; ai < 2; ++ai)
#pragma unroll
                for (int m = 0; m < 4; ++m) q_[ai][m] = u.sc[r0 + ai * 128 + m * 16];
#pragma unroll
            for (int ai = 0; ai < 2; ++ai)
#pragma unroll
                for (int m = 0; m < 4; ++m) rsv[ai][m] = rsqrtf(u64f(q_[ai][m]) * SSQ_INV + EPS);
        } else {
#pragma unroll
            for (int ai = 0; ai < 2; ++ai)
#pragma unroll
                for (int m = 0; m < 4; ++m) rsv[ai][m] = 1.f;
        }
#pragma unroll
        for (int ai = 0; ai < 2; ++ai)
#pragma unroll
            for (int m = 0; m < 4; ++m) {
                const int row = r0 + ai * 128 + m * 16;
                const float rs = rsv[ai][m];
                bf16_t* rowp = u.out + (size_t)row * u.ldc + c0;
#pragma unroll
                for (int bj = 0; bj < 2; ++bj) {
                    if (bj == 1 && (u.mode & 8)) continue;
                    f32x4 v0 = acc[ai][bj][m][0] * cs[bj][0] * rs, v1 = acc[ai][bj][m][1] * cs[bj][1] * rs;
                    u32x4 w; w.x = cvt_pk_bf16(v0[0], v0[1]); w.y = cvt_pk_bf16(v0[2], v0[3]); w.z = cvt_pk_bf16(v1[0], v1[1]); w.w = cvt_pk_bf16(v1[2], v1[3]);
                    *(u32x4*)(rowp + bj * 128) = w;
                    if (bj == 0 && u.gates != nullptr && wc == 0) { float* gp = u.gates + (size_t)row * 32 + 8 * fq; *(f32x4*)gp = v0; *(f32x4*)(gp + 4) = v1; }
                }
            }
    }
};

__device__ __forceinline__ void tile_order(int wgid, int nM, int nN, int& pm, int& pn) {
    const int nwg = nM * nN; { const int q = nwg / 8, r = nwg % 8, xcd = wgid % 8, off = wgid / 8; wgid = (xcd < r ? xcd * (q + 1) : r * (q + 1) + (xcd - r) * q) + off; }
    const int nig = 8 * nN, gid = wgid / nig, fm = gid * 8, gsz = (nM - fm) < 8 ? (nM - fm) : 8;
    pm = fm + ((wgid % nig) % gsz); pn = (wgid % nig) / gsz;
}

struct SchedIn {
    typedef GU Unit;
    unsigned char* ws; int l, nkv, G, c;
    __device__ __forceinline__ bool next(int i, AB& u) const {
        int Lx = i * G + c;
        const char* hb = (const char*)(ws + WS_HB); const char* wt = (const char*)(ws + WS_W + (size_t)l * SZ_LAYER + OF_WIN);
        if (Lx < 448) { int pm, pn; tile_order(Lx, 32, 14, pm, pn); u.A = hb + (size_t)pm * 256 * D_ * 2; u.B = wt + (size_t)pn * 256 * D_ * 2; return true; }
        Lx -= 448;
        if (Lx < 160) { const int pm = Lx % 5, pn = Lx / 5; u.A = wt + (size_t)(NP + pm * 256) * D_ * 2; u.B = hb + (size_t)pn * 256 * D_ * 2; return true; }
        Lx -= 160;
        if (Lx < nkv) { const int lk = Lx >> 2, j = Lx & 3; const char* w = (const char*)(ws + WS_W + OF_WKV + (size_t)lk * SZ_LAYER); const char* memb = (const char*)(ws + WS_MEMB);
            if (j < 2) { u.A = memb; u.B = w + (size_t)j * 256 * D_ * 2; } else { u.A = w + (size_t)(512 + (j - 2) * 256) * D_ * 2; u.B = memb; }
            return true; }
        return false;
    }
    __device__ __forceinline__ GU full(int i) const {
        GU u; int Lx = i * G + c; const u64* ssq = (const u64*)(ws + WS_SSQ) + (3 * l) * T_;
        if (Lx < 448) { int pm, pn; tile_order(Lx, 32, 14, pm, pn);
            u.out = (bf16_t*)(ws + WS_PROJ) + (size_t)pm * 256 * NP + pn * 256; u.sc = ssq + pm * 256;
            u.gates = (pn == 13) ? (float*)(ws + WS_GATES) + (size_t)pm * 256 * 32 : nullptr; u.ldc = NP; u.mode = 1; return u; }
        Lx -= 448;
        if (Lx < 160) { const int pm = Lx % 5, pn = Lx / 5;
            u.out = (bf16_t*)(ws + WS_VT) + (size_t)pm * 256 * T_ + pn * 256; u.sc = ssq + pn * 256; u.gates = nullptr; u.ldc = T_; u.mode = 2; return u; }
        Lx -= 160;
        { const int lk = Lx >> 2, j = Lx & 3; u.sc = nullptr; u.gates = nullptr; u.mode = 0;
            if (j < 2) { u.out = (bf16_t*)(ws + WS_KX) + (size_t)lk * 256 * 512 + j * 256; u.ldc = 512; }
            else { u.out = (bf16_t*)(ws + WS_VXT) + (size_t)lk * 512 * 256 + (size_t)(j - 2) * 256 * 256; u.ldc = 256; } }
        return u;
    }
};
struct SchedRow {
    typedef GU Unit;
    const char* A; const char* B; bf16_t* out; const u64* ssq; int nM, nN, K, G, c;
    __device__ __forceinline__ bool next(int i, AB& u) const {
        const int Lx = i * G + c; if (Lx >= nM * nN) return false;
        int pm, pn; tile_order(Lx, nM, nN, pm, pn);
        u.A = A + (size_t)pm * 256 * K * 2; u.B = B + (size_t)pn * 256 * K * 2; return true;
    }
    __device__ __forceinline__ GU full(int i) const {
        GU u; const int Lx = i * G + c; int pm, pn; tile_order(Lx, nM, nN, pm, pn);
        u.out = out + (size_t)pm * 256 * (nN * 256) + pn * 256; u.sc = ssq + pm * 256; u.gates = nullptr; u.ldc = nN * 256; u.mode = 1; return u;
    }
};
struct SchedQH {
    typedef GU Unit;
    unsigned char* ws; int l, G, c;
    __device__ __forceinline__ bool next(int i, AB& u) const {
        const int Lx = i * G + c; if (Lx >= 128) return false;
        u.A = (const char*)(ws + WS_HB) + (size_t)(Lx & 31) * 256 * D_ * 2; u.B = (const char*)(ws + WS_W + (size_t)l * SZ_LAYER + OF_WQ) + (size_t)(Lx >> 5) * 128 * D_ * 2; return true;
    }
    __device__ __forceinline__ GU full(int i) const { const int Lx = i * G + c, pm = Lx & 31, pq = Lx >> 5; GU u;
        u.out = (bf16_t*)(ws + WS_QX) + (size_t)pm * 256 * 512 + pq * 128; u.sc = (const u64*)(ws + WS_SSQ) + (3 * l + 1) * T_ + pm * 256; u.gates = nullptr; u.ldc = 512; u.mode = 1 | 8; return u; }
};
struct RU { int pm, pn; };
struct SchedR {
    typedef RU Unit;
    const char* A; const char* B; int K, G, c;
    __device__ __forceinline__ bool next(int i, AB& u) const {
        const int Lx = i * G + c; if (Lx >= 256) return false;
        u.A = A + (size_t)(Lx & 31) * 256 * K * 2; u.B = B + (size_t)(Lx >> 5) * 256 * K * 2; return true;
    }
    __device__ __forceinline__ RU full(int i) const { const int Lx = i * G + c; RU u; u.pm = Lx & 31; u.pn = Lx >> 5; return u; }
};
struct EpiR {
    static constexpr bool PERM = true;
    bf16_t* hb; u64* ssq; LAS float* red;
    __device__ __forceinline__ void operator()(const f32x4 (&acc)[2][2][4][2], const RU& u, int wr, int wc, int fr, int fq) const {
        const int col0 = u.pn * 256 + wc * 32 + 8 * fq, ln_ = fq * 16 + fr;
        u32x4 bb[2][4][2];
#pragma unroll
        for (int ai = 0; ai < 2; ++ai)
#pragma unroll
            for (int m = 0; m < 4; ++m) { const bf16_t* rp = hb + (size_t)(u.pm * 256 + ai * 128 + wr * 64 + m * 16 + fr) * D_ + col0; bb[ai][m][0] = *(const u32x4*)rp; bb[ai][m][1] = *(const u32x4*)(rp + 128); }
#pragma unroll
        for (int ai = 0; ai < 2; ++ai)
#pragma unroll
            for (int m = 0; m < 4; ++m) {
                const int row = u.pm * 256 + ai * 128 + wr * 64 + m * 16 + fr; float sq = 0.f;
                bf16_t* rp = hb + (size_t)row * D_ + col0;
#pragma unroll
                for (int bj = 0; bj < 2; ++bj) {
                    const u32x4 b = bb[ai][m][bj];
                    const f32x4 v0 = acc[ai][bj][m][0] + (f32x4){bflo(b.x), bfhi(b.x), bflo(b.y), bfhi(b.y)};
                    const f32x4 v1 = acc[ai][bj][m][1] + (f32x4){bflo(b.z), bfhi(b.z), bflo(b.w), bfhi(b.w)};
                    u32x4 w; w.x = cvt_pk_bf16(v0[0], v0[1]); w.y = cvt_pk_bf16(v0[2], v0[3]); w.z = cvt_pk_bf16(v1[0], v1[1]); w.w = cvt_pk_bf16(v1[2], v1[3]);
                    *(u32x4*)(rp + bj * 128) = w;
                    sq += ((v0[0] * v0[0] + v0[1] * v0[1]) + (v0[2] * v0[2] + v0[3] * v0[3])) + ((v1[0] * v1[0] + v1[1] * v1[1]) + (v1[2] * v1[2] + v1[3] * v1[3]));
                }
                sq += shx(sq, 16, ln_); sq += shx(sq, 32, ln_);
                if (fq == 0) red[wc * 256 + ai * 128 + wr * 64 + m * 16 + fr] = sq;
            }
        asm volatile("s_waitcnt lgkmcnt(0)" ::: "memory"); __builtin_amdgcn_s_barrier(); asm volatile("" ::: "memory");
        { const int t_ = (wr * 4 + wc) * 64 + ln_;
          if (t_ < 256) atomicAdd(ssq + u.pm * 256 + t_, (u64)__float2ull_rn(((red[t_] + red[256 + t_]) + (red[512 + t_] + red[768 + t_])) * SSQ_SCALE)); }
    }
};


struct CU2 { int pm, pn; };
struct SchedUp {
    typedef CU2 Unit;
    unsigned char* ws; int l, G, c;
    __device__ __forceinline__ bool next(int i, AB& u) const {
        const int Lx = i * G + c; if (Lx >= 33 * 44) return false;
        int pm, pn; tile_order(Lx, 33, 44, pm, pn);
        u.A = (const char*)(ws + WS_HB) + ((long)pm * 254 - 2) * (D_ * 2); u.B = (const char*)(ws + WS_W + (size_t)l * SZ_LAYER + OF_WUP) + (size_t)pn * 256 * D_ * 2; return true;
    }
    __device__ __forceinline__ CU2 full(int i) const { const int Lx = i * G + c; CU2 u; tile_order(Lx, 33, 44, u.pm, u.pn); return u; }
};
__device__ __forceinline__ float dpp_ror1(float v) { return __int_as_float(__builtin_amdgcn_mov_dpp(__float_as_int(v), 0x121, 0xF, 0xF, true)); }
__device__ __forceinline__ float dpp_ror2(float v) { return __int_as_float(__builtin_amdgcn_mov_dpp(__float_as_int(v), 0x122, 0xF, 0xF, true)); }
struct EpiC {
    static constexpr bool PERM = true;
    const Params& p; unsigned char* ws; int l; LAS float* hal;
    __device__ __forceinline__ void operator()(const f32x4 (&acc)[2][2][4][2], const CU2& u, int wr, int wc, int fr_, int fq_) const {
        int ln0 = (int)__builtin_amdgcn_mbcnt_hi(~0u, __builtin_amdgcn_mbcnt_lo(~0u, 0u)); asm volatile("" : "+v"(ln0)); const int fr = ln0 & 15, fq = ln0 >> 4;
        int cl = 32 * wc + 8 * fq, rb = 128 * wr + 8 * fr; asm volatile("" : "+v"(cl), "+v"(rb));
        const int t0 = 254 * u.pm - 2, tb = t0 + rb;
        const u64* ssq = (const u64*)(ws + WS_SSQ) + (3 * l + 2) * T_; const float* cw = p.conv_w + (size_t)l * 3 * 2 * FF_; const float* cb = p.conv_b + (size_t)l * 2 * FF_; bf16_t* act = (bf16_t*)(ws + WS_ACT);
        float rsv[8];
        { u64 q_[8];
#pragma unroll
          for (int j = 0; j < 8; ++j) q_[j] = ssq[(unsigned)(tb + j) < (unsigned)T_ ? tb + j : 0];
#pragma unroll
          for (int j = 0; j < 8; ++j) rsv[j] = (unsigned)(tb + j) < (unsigned)T_ ? rsqrtf(u64f(q_[j]) * SSQ_INV + EPS) : 0.f; }
        if (wr == 0 && fr == 15) {
#pragma unroll
            for (int bj = 0; bj < 2; ++bj)
#pragma unroll
                for (int n = 0; n < 2; ++n) { *(LAS f32x4*)(hal + 128 * bj + cl + 4 * n) = acc[1][bj][2][n] * rsv[6]; *(LAS f32x4*)(hal + 256 + 128 * bj + cl + 4 * n) = acc[1][bj][3][n] * rsv[7]; }
        }
        asm volatile("s_waitcnt lgkmcnt(0)" ::: "memory"); __builtin_amdgcn_s_barrier(); asm volatile("" ::: "memory");
#pragma unroll
        for (int n = 0; n < 2; ++n) {
            const float* wp = cw + 128 * u.pn + cl + 4 * n; const float* bp = cb + 128 * u.pn + cl + 4 * n;
            const f32x4 g0 = *(const f32x4*)wp, g1 = *(const f32x4*)(wp + 2 * FF_), g2 = *(const f32x4*)(wp + 4 * FF_), gb = *(const f32x4*)bp;
            const f32x4 v0 = *(const f32x4*)(wp + FF_), v1 = *(const f32x4*)(wp + 3 * FF_), v2 = *(const f32x4*)(wp + 5 * FF_), vb = *(const f32x4*)(bp + FF_);
            f32x4 pg2 = acc[1][0][2][n] * rsv[6], pg1 = acc[1][0][3][n] * rsv[7], pv2 = acc[1][1][2][n] * rsv[6], pv1 = acc[1][1][3][n] * rsv[7];
#pragma unroll
            for (int e = 0; e < 4; ++e) {
                pg2[e] = __int_as_float(__builtin_amdgcn_mov_dpp(__float_as_int(pg2[e]), 0x111, 0xF, 0xF, true)); pg1[e] = __int_as_float(__builtin_amdgcn_mov_dpp(__float_as_int(pg1[e]), 0x111, 0xF, 0xF, true));
                pv2[e] = __int_as_float(__builtin_amdgcn_mov_dpp(__float_as_int(pv2[e]), 0x111, 0xF, 0xF, true)); pv1[e] = __int_as_float(__builtin_amdgcn_mov_dpp(__float_as_int(pv1[e]), 0x111, 0xF, 0xF, true));
            }
            if (fr == 0 && wr == 1) { pg2 = *(const LAS f32x4*)(hal + cl + 4 * n); pg1 = *(const LAS f32x4*)(hal + 256 + cl + 4 * n); pv2 = *(const LAS f32x4*)(hal + 128 + cl + 4 * n); pv1 = *(const LAS f32x4*)(hal + 384 + cl + 4 * n); }
#pragma unroll
            for (int j = 0; j < 8; ++j) {
                const f32x4 xg = acc[j >> 2][0][j & 3][n] * rsv[j], xv = acc[j >> 2][1][j & 3][n] * rsv[j];
                const f32x4 gc = gb + g2 * xg + g1 * pg1 + g0 * pg2, vc = vb + v2 * xv + v1 * pv1 + v0 * pv2;
                f32x4 sg;
#pragma unroll
                for (int e = 0; e < 4; ++e) sg[e] = __builtin_amdgcn_rcpf(1.f + __expf(-gc[e]));
                const f32x4 o4 = gc * sg * vc;
                pg2 = pg1; pg1 = xg; pv2 = pv1; pv1 = xv;
                if (rb + j >= 2 && tb + j < T_) { u32x2 w; w.x = cvt_pk_bf16(o4[0], o4[1]); w.y = cvt_pk_bf16(o4[2], o4[3]); *(u32x2*)(act + (size_t)(tb + j) * FF_ + 128 * u.pn + cl + 4 * n) = w; }
                __builtin_amdgcn_sched_barrier(0);
            }
        }
    }
};

constexpr int AT_KROW = 272, AT_VROW = 144, AT_KBUF = 64 * AT_KROW, AT_VBUF = 128 * AT_VROW, AT_BUF = AT_KBUF + AT_VBUF + 256;
constexpr int AT_T5 = 73728;
template <int MODE>
__device__ __forceinline__ void attn_unit(LAS unsigned char* lds, const int tid_in, const bf16_t* Qrow, const bf16_t* Kb, int kpitch, const bf16_t* VTb, int vpitch, int kt0, int kt1,
                                          int t_row, int tq0, const float* cb, float m_init, float l_init, const LAS float* t5, bf16_t* Orow, float kn = 0.f) {
    int tid = tid_in; asm volatile("" : "+v"(tid));
    const int lane = tid & 63, r = lane & 31, hh = lane >> 5;
    constexpr float SC = 0.08838834764831845f * LOG2E;
    bf16x8 qf[8];
#pragma unroll
    for (int ks = 0; ks < 8; ++ks) qf[ks] = *(const bf16x8*)(Qrow + 16 * ks + 8 * hh);
    f32x16 o[4];
#pragma unroll
    for (int db = 0; db < 4; ++db)
#pragma unroll
        for (int i = 0; i < 16; ++i) o[db][i] = 0.f;
    float m = m_init, l = (hh == 0) ? l_init : 0.f;
    const int pr = (r & ~12) | ((r & 4) << 1) | ((r & 8) >> 1);
    const unsigned koff = pr * AT_KROW + 16 * hh, voff = AT_KBUF + r * AT_VROW + 16 * hh;
    const int kkey0 = tid >> 4, kc16 = tid & 15, vd0 = tid >> 3, vc8 = tid & 7;
    u32x4 kreg[2], vreg[2]; float creg = 0.f;
#define AT_LOAD(kt) do { const int k0_ = (kt) * 64; \
        kreg[0] = *(const u32x4*)(Kb + (size_t)(k0_ + kkey0) * kpitch + kc16 * 8); kreg[1] = *(const u32x4*)(Kb + (size_t)(k0_ + kkey0 + 32) * kpitch + kc16 * 8); \
        vreg[0] = *(const u32x4*)(VTb + (size_t)vd0 * vpitch + k0_ + vc8 * 8); vreg[1] = *(const u32x4*)(VTb + (size_t)(vd0 + 64) * vpitch + k0_ + vc8 * 8); \
        if (MODE == 0 && tid < 64) creg = cb[k0_ + tid]; } while (0)
#define AT_WRITE(b) do { LAS unsigned char* base_ = lds + (b) * AT_BUF; \
        *(LAS u32x4*)(base_ + kkey0 * AT_KROW + kc16 * 16) = kreg[0]; *(LAS u32x4*)(base_ + (kkey0 + 32) * AT_KROW + kc16 * 16) = kreg[1]; \
        *(LAS u32x4*)(base_ + AT_KBUF + vd0 * AT_VROW + vc8 * 16) = vreg[0]; *(LAS u32x4*)(base_ + AT_KBUF + (vd0 + 64) * AT_VROW + vc8 * 16) = vreg[1]; \
        if (MODE == 0 && tid < 64) *(LAS float*)(base_ + AT_KBUF + AT_VBUF + tid * 4) = -creg * LOG2E; } while (0)
    float qn = 0.f; bool wdone = false;
    LAS unsigned* flg = (LAS unsigned*)(lds + 2 * AT_BUF);
    if (MODE == 0) {
#pragma unroll
        for (int ks = 0; ks < 8; ++ks) { const u32x4 qq = __builtin_bit_cast(u32x4, qf[ks]);
            qn += bflo(qq.x) * bflo(qq.x) + bfhi(qq.x) * bfhi(qq.x) + bflo(qq.y) * bflo(qq.y) + bfhi(qq.y) * bfhi(qq.y) + bflo(qq.z) * bflo(qq.z) + bfhi(qq.z) * bfhi(qq.z) + bflo(qq.w) * bflo(qq.w) + bfhi(qq.w) * bfhi(qq.w); }
        qn = xsum(qn); qn = sqrtf(qn) * kn * SC * 1.0001f + 1e-3f;
    }
    AT_LOAD(kt1 - 1); AT_WRITE(0); __syncthreads();
#pragma unroll 1
    for (int kt = kt1 - 1; kt >= kt0; --kt) {
        const int cur = (kt1 - 1 - kt) & 1, k0 = kt * 64;
        if (kt > kt0) AT_LOAD(kt - 1);
        bool active = true;
        if (MODE == 0) active = (k0 <= tq0 + 31) && !wdone;
        if (MODE == 1) active = (k0 <= tq0 + 31) && (k0 + 63 > tq0 - 128);
        if (active) {
            const LAS unsigned char* base = lds + cur * AT_BUF;
            f32x16 s0, s1;
#pragma unroll
            for (int i = 0; i < 16; ++i) { s0[i] = 0.f; s1[i] = 0.f; }
            {
                bf16x8 ka[8];
#pragma unroll
                for (int ks = 0; ks < 8; ++ks) ka[ks] = *(const LAS bf16x8*)(base + koff + ks * 32);
                __builtin_amdgcn_sched_barrier(0);
#pragma unroll
                for (int ks = 0; ks < 8; ++ks) s0 = MFMA32(ka[ks], qf[ks], s0);
                __builtin_amdgcn_sched_barrier(0);
#pragma unroll
                for (int ks = 0; ks < 8; ++ks) ka[ks] = *(const LAS bf16x8*)(base + 32 * AT_KROW + koff + ks * 32);
                __builtin_amdgcn_sched_barrier(0);
#pragma unroll
                for (int ks = 0; ks < 8; ++ks) s1 = MFMA32(ka[ks], qf[ks], s1);
            }
            float x[32];
            const LAS float* cbl = (const LAS float*)(base + AT_KBUF + AT_VBUF);
            const bool need_mask = (MODE == 0) ? (k0 + 63 > tq0) : true;
            float mx = NEG;
            if (MODE == 1) {
#pragma unroll
                for (int i = 0; i < 32; ++i) { const int ii = i & 15, kl = 32 * (i >> 4) + (ii & 7) + 8 * hh + 16 * (ii >> 3); x[i] = t5[(t_row - (k0 + kl)) & 127]; }
                __builtin_amdgcn_sched_barrier(0);
            }
#pragma unroll
            for (int i = 0; i < 32; ++i) {
                const int blk = i >> 4, ii = i & 15, kl = 32 * blk + (ii & 7) + 8 * hh + 16 * (ii >> 3);
                float v = (blk ? s1[ii] : s0[ii]) * SC;
                if (MODE == 0) v += cbl[kl];
                if (MODE == 1) { const int rel = t_row - (k0 + kl); v = ((unsigned)rel < 128u) ? v + x[i] : NEG; }
                x[i] = v;
            }
            if (MODE == 0 && need_mask) {
#pragma unroll
                for (int i = 0; i < 32; ++i) { const int ii = i & 15, kl = 32 * (i >> 4) + (ii & 7) + 8 * hh + 16 * (ii >> 3); if (k0 + kl > t_row) x[i] = NEG; }
            }
#pragma unroll
            for (int i = 0; i < 32; ++i) mx = fmaxf(mx, x[i]);
            mx = xmax(mx);
            const float mn = fmaxf(m, mx), alpha = ex2(m - mn); m = mn;
            float rs = 0.f;
#pragma unroll
            for (int i = 0; i < 32; ++i) { x[i] = ex2(x[i] - mn); rs += x[i]; }
            l = l * alpha + rs;
#pragma unroll
            for (int db = 0; db < 4; ++db)
#pragma unroll
                for (int i = 0; i < 16; ++i) o[db][i] *= alpha;
            bf16x8 pf[4];
#pragma unroll
            for (int j = 0; j < 4; ++j) pf[j] = pack8(x[8 * j], x[8 * j + 1], x[8 * j + 2], x[8 * j + 3], x[8 * j + 4], x[8 * j + 5], x[8 * j + 6], x[8 * j + 7]);
#pragma unroll
            for (int jh = 0; jh < 2; ++jh) {
                bf16x8 va[2][4];
#pragma unroll
                for (int j = 0; j < 2; ++j)
#pragma unroll
                    for (int db = 0; db < 4; ++db) va[j][db] = *(const LAS bf16x8*)(base + voff + db * 32 * AT_VROW + (2 * jh + j) * 32);
                __builtin_amdgcn_sched_barrier(0);
#pragma unroll
                for (int j = 0; j < 2; ++j)
#pragma unroll
                    for (int db = 0; db < 4; ++db) o[db] = MFMA32(va[j][db], pf[2 * jh + j], o[db]);
                __builtin_amdgcn_sched_barrier(0);
            }
            if (MODE == 0 && kt > kt0 && k0 <= tq0) {
                const float ub = qn + cbl[0];
                wdone = __all(ub < m - 30.f);
            }
        }
        if (kt > kt0) AT_WRITE(cur ^ 1);
        if (MODE == 0) { if (lane == 0) flg[cur * 8 + (tid >> 6)] = wdone ? 0u : 1u; }
        __syncthreads();
        if (MODE == 0) { const u32x4 f0 = *(const LAS u32x4*)(flg + cur * 8), f1 = *(const LAS u32x4*)(flg + cur * 8 + 4);
            if (((f0.x | f0.y) | (f0.z | f0.w) | (f1.x | f1.y) | (f1.z | f1.w)) == 0u) break; }
    }
    if (MODE == 0) __syncthreads();
#undef AT_LOAD
#undef AT_WRITE
    l = xsum(l);
    const float inv = 1.f / l;
#pragma unroll
    for (int db = 0; db < 4; ++db)
#pragma unroll
        for (int g = 0; g < 4; g += 2) {
            unsigned ax = cvt_pk_bf16(o[db][4 * g] * inv, o[db][4 * g + 1] * inv), ay = cvt_pk_bf16(o[db][4 * g + 2] * inv, o[db][4 * g + 3] * inv);
            unsigned bx = cvt_pk_bf16(o[db][4 * g + 4] * inv, o[db][4 * g + 5] * inv), by = cvt_pk_bf16(o[db][4 * g + 6] * inv, o[db][4 * g + 7] * inv);
            const auto rx = __builtin_amdgcn_permlane32_swap(ax, bx, false, false), ry = __builtin_amdgcn_permlane32_swap(ay, by, false, false);
            u32x4 w; w.x = rx[0]; w.y = ry[0]; w.z = rx[1]; w.w = ry[1];
            *(u32x4*)(Orow + 32 * db + 8 * g + 8 * hh) = w;
        }
}

template <int MODEC>
__device__ __forceinline__ void gla_unit(LAS unsigned char* lds, const int tid_in, const Params& p, int l, int hh, int n) {
    int tid = tid_in; asm volatile("" : "+v"(tid));
    const int lane = tid & 63, w = __builtin_amdgcn_readfirstlane(tid >> 6), r = lane & 31, h2 = lane >> 5;
    unsigned char* ws = p.ws; asm volatile("" : "+s"(ws));
    const float* gates = (const float*)(ws + WS_GATES); const bf16_t* proj = (const bf16_t*)(ws + WS_PROJ); const bf16_t* vT = (const bf16_t*)(ws + WS_VT);
    float* kvb = (float*)(ws + WS_KVB); float* dec = (float*)(ws + WS_DEC);
    LAS float* bmat = (LAS float*)lds; LAS float* seg = (LAS float*)(lds + 16384); LAS float* blast = (LAS float*)(lds + 18432);
    LAS bf16_t* QT = (LAS bf16_t*)(lds + 18688); LAS bf16_t* KT = (LAS bf16_t*)(lds + 27904); LAS float* ss = (LAS float*)(lds + 37120);
    const int t0 = 64 * n;
    {
        const int d = lane; const float* wg = p.w_gla_gate + (size_t)l * 16 * 256 + hh * 64 + d; const float bgv = p.b_gla_gate[l * 256 + hh * 64 + d];
        float wgr[16];
#pragma unroll
        for (int q = 0; q < 16; ++q) wgr[q] = wg[q * 256];
        LAS float* gl = (LAS float*)(lds + 38400);
        if (tid < 256) *(LAS f32x4*)(gl + (tid >> 2) * 16 + (tid & 3) * 4) = *(const f32x4*)(gates + (size_t)(t0 + (tid >> 2)) * 32 + 4 + (tid & 3) * 4);
        __syncthreads();
        float pcs[8]; float run = 0.f;
#pragma unroll
        for (int j = 0; j < 8; ++j) { const LAS float* gp = gl + (w * 8 + j) * 16; float z = bgv;
#pragma unroll
            for (int q = 0; q < 16; ++q) z += gp[q] * wgr[q];
            run += logsig(z) * (1.f / 16.f); pcs[j] = run; }
        seg[w * 64 + d] = run; __syncthreads();
        float off = 0.f, tot = 0.f;
#pragma unroll
        for (int g = 0; g < 8; ++g) { const float sv = seg[g * 64 + d]; tot += sv; if (g < w) off += sv; }
#pragma unroll
        for (int j = 0; j < 8; ++j) bmat[(w * 8 + j) * 64 + d] = off + pcs[j];
        if (w == 0) blast[d] = tot;
        __syncthreads();
    }
    const int s = tid >> 3, dk8 = (tid & 7) * 8;
    if (MODEC == 0) {
        const u32x4 kk = *(const u32x4*)(proj + (size_t)(t0 + s) * NP + PJ_GK + hh * 64 + dk8);
        const unsigned kw[4] = {kk.x, kk.y, kk.z, kk.w};
#pragma unroll
        for (int j = 0; j < 8; ++j) { const float kf = ((j & 1) ? bfhi(kw[j >> 1]) : bflo(kw[j >> 1])) * __expf(blast[dk8 + j] - bmat[s * 64 + dk8 + j]);
            QT[(dk8 + j) * 72 + s] = (bf16_t)(cvt_pk_bf16(kf, 0.f) & 0xffffu); }
        if (tid < 64) dec[(size_t)(hh * 128 + n) * 64 + tid] = __expf(blast[tid]);
        __syncthreads();
        const int dvb = w & 3, dkb = w >> 2;
        f32x16 acc;
#pragma unroll
        for (int i = 0; i < 16; ++i) acc[i] = 0.f;
        bf16x8 va[4];
#pragma unroll
        for (int ks = 0; ks < 4; ++ks) va[ks] = *(const bf16x8*)(vT + (size_t)(VT_G + hh * 128 + 32 * dvb + r) * T_ + t0 + 16 * ks + 8 * h2);
#pragma unroll
        for (int ks = 0; ks < 4; ++ks) {
            const bf16x8 b = *(const LAS bf16x8*)(QT + (32 * dkb + r) * 72 + 16 * ks + 8 * h2);
            acc = MFMA32(va[ks], b, acc);
        }
        float* kp = kvb + (size_t)(hh * 128 + n) * 128 * 64 + 32 * dkb + r;
#pragma unroll
        for (int i = 0; i < 16; ++i) { const int dv = 32 * dvb + (i & 3) + 8 * (i >> 2) + 4 * h2; kp[(size_t)dv * 64] = acc[i]; }
        __syncthreads();
    } else {
        const u32x4 qq = *(const u32x4*)(proj + (size_t)(t0 + s) * NP + PJ_GQ + hh * 64 + dk8);
        const u32x4 kk = *(const u32x4*)(proj + (size_t)(t0 + s) * NP + PJ_GK + hh * 64 + dk8);
        const unsigned qw[4] = {qq.x, qq.y, qq.z, qq.w}, kw[4] = {kk.x, kk.y, kk.z, kk.w};
        float qv[8], kv[8];
#pragma unroll
        for (int j = 0; j < 8; ++j) { const float b = bmat[s * 64 + dk8 + j];
            qv[j] = ((j & 1) ? bfhi(qw[j >> 1]) : bflo(qw[j >> 1])) * 0.125f * __expf(b);
            kv[j] = ((j & 1) ? bfhi(kw[j >> 1]) : bflo(kw[j >> 1])) * __expf(-b); }
        *(LAS bf16x8*)(QT + s * 72 + dk8) = pack8(qv[0], qv[1], qv[2], qv[3], qv[4], qv[5], qv[6], qv[7]);
        *(LAS bf16x8*)(KT + s * 72 + dk8) = pack8(kv[0], kv[1], kv[2], kv[3], kv[4], kv[5], kv[6], kv[7]);
        __syncthreads();
        const int dvb = w & 3, tb = w >> 2, tt = 32 * tb + r;
        const int pr = (r & ~12) | ((r & 4) << 1) | ((r & 8) >> 1);
        bf16x8 qfr[4];
#pragma unroll
        for (int ks = 0; ks < 4; ++ks) qfr[ks] = *(const LAS bf16x8*)(QT + tt * 72 + 16 * ks + 8 * h2);
        f32x16 acc;
#pragma unroll
        for (int i = 0; i < 16; ++i) acc[i] = 0.f;
        bf16x8 vfr[2][2]; f32x4 sfr[4][2];
#pragma unroll
        for (int sb = 0; sb < 2; ++sb)
#pragma unroll
            for (int kk2 = 0; kk2 < 2; ++kk2) vfr[sb][kk2] = *(const bf16x8*)(vT + (size_t)(VT_G + hh * 128 + 32 * dvb + r) * T_ + t0 + 32 * sb + 16 * kk2 + 8 * h2);
        { const float* sp_ = kvb + ((size_t)(hh * 128 + n) * 128 + 32 * dvb + r) * 64 + 8 * h2;
#pragma unroll
          for (int ks = 0; ks < 4; ++ks) { sfr[ks][0] = *(const f32x4*)(sp_ + 16 * ks); sfr[ks][1] = *(const f32x4*)(sp_ + 16 * ks + 4); } }
#pragma unroll
        for (int sb = 0; sb < 2; ++sb) {
            if (sb <= tb) {
                f32x16 sa;
#pragma unroll
                for (int i = 0; i < 16; ++i) sa[i] = 0.f;
#pragma unroll
                for (int ks = 0; ks < 4; ++ks) { const bf16x8 a = *(const LAS bf16x8*)(KT + (32 * sb + pr) * 72 + 16 * ks + 8 * h2); sa = MFMA32(a, qfr[ks], sa); }
#pragma unroll
                for (int i = 0; i < 16; ++i) { const int sl = 32 * sb + (i & 7) + 8 * h2 + 16 * (i >> 3); if (sl > tt) sa[i] = 0.f; }
#pragma unroll
                for (int kk2 = 0; kk2 < 2; ++kk2) {
                    const bf16x8 pfr = pack8(sa[8 * kk2], sa[8 * kk2 + 1], sa[8 * kk2 + 2], sa[8 * kk2 + 3], sa[8 * kk2 + 4], sa[8 * kk2 + 5], sa[8 * kk2 + 6], sa[8 * kk2 + 7]);
                    acc = MFMA32(vfr[sb][kk2], pfr, acc);
                }
            }
        }
#pragma unroll
        for (int ks = 0; ks < 4; ++ks) {
            const f32x4 s0 = sfr[ks][0], s1 = sfr[ks][1];
            const bf16x8 a = pack8(s0[0], s0[1], s0[2], s0[3], s1[0], s1[1], s1[2], s1[3]);
            acc = MFMA32(a, qfr[ks], acc);
        }
        float part = 0.f;
#pragma unroll
        for (int i = 0; i < 16; ++i) part += acc[i] * acc[i];
        part += shx(part, 32, lane);
        if (h2 == 0) ss[tt * 4 + dvb] = part;
        __syncthreads();
        const float tot = (ss[tt * 4] + ss[tt * 4 + 1]) + (ss[tt * 4 + 2] + ss[tt * 4 + 3]);
        const float rstd = rsqrtf(tot * (1.f / 128.f) + EPS);
        bf16_t* op = (bf16_t*)(ws + WS_O) + (size_t)(t0 + tt) * D_ + 1536 + hh * 128;
        const bf16_t* grp = proj + (size_t)(t0 + tt) * NP + PJ_GR + hh * 128;
        const float* gn = p.gla_norm + l * 128;
#pragma unroll
        for (int g = 0; g < 4; ++g) {
            const int dv = 32 * dvb + 8 * g + 4 * h2;
            const u32x2 gw = *(const u32x2*)(grp + dv); const f32x4 gnv = *(const f32x4*)(gn + dv);
            const float g0 = bflo(gw.x), g1 = bfhi(gw.x), g2 = bflo(gw.y), g3 = bfhi(gw.y);
            const float v0 = acc[4 * g] * rstd * gnv[0] * (g0 * __builtin_amdgcn_rcpf(1.f + __expf(-g0))), v1 = acc[4 * g + 1] * rstd * gnv[1] * (g1 * __builtin_amdgcn_rcpf(1.f + __expf(-g1)));
            const float v2 = acc[4 * g + 2] * rstd * gnv[2] * (g2 * __builtin_amdgcn_rcpf(1.f + __expf(-g2))), v3 = acc[4 * g + 3] * rstd * gnv[3] * (g3 * __builtin_amdgcn_rcpf(1.f + __expf(-g3)));
            u32x2 wv; wv.x = cvt_pk_bf16(v0, v1); wv.y = cvt_pk_bf16(v2, v3); *(u32x2*)(op + dv) = wv;
        }
        __syncthreads();
    }
}

__device__ __forceinline__ int inmap(int nd) {
    if (nd < 1024) return nd;
    if (nd < 2048) return 1540 + nd - 1024;
    if (nd < 2304) return 2564 + nd - 2048;
    if (nd < 2560) return 3076 + nd - 2304;
    if (nd < 2816) return 3332 + nd - 2560;
    if (nd < 3328) return 4100 + nd - 2816;
    if (nd < 3332) return 1536 + nd - 3328;
    if (nd < 3348) return 4612 + nd - 3332;
    if (nd < 3584) return -1;
    if (nd < 4096) return 1024 + nd - 3584;
    if (nd < 4352) return 2820 + nd - 4096;
    return 3588 + nd - 4352;
}
__device__ __forceinline__ int upmap(int nd) { const int pn = nd >> 8, q = nd & 255; return q < 128 ? 128 * pn + q : FF_ + 128 * pn + (q - 128); }
template <int MAPK>
__device__ __forceinline__ void transpose_item(const float* W, int K, int N, int ND, bf16_t* WT, const float* g, LAS float* scr, int item, int lane) {
    const int nblk = ND / 64, kb = item / nblk, nb = item % nblk, k0 = 64 * kb, n0 = 64 * nb;
    const int c4 = (lane & 15) * 4, kr = lane >> 4;
    int src = n0 + c4; if (MAPK == 1) src = inmap(src); if (MAPK == 2) src = upmap(src);
    f32x4 vv[16];
#pragma unroll
    for (int i = 0; i < 16; ++i) { const int kk = 4 * i + kr;
        vv[i] = (f32x4){0.f, 0.f, 0.f, 0.f};
        if (src >= 0) vv[i] = *(const f32x4*)(W + (size_t)(k0 + kk) * N + src); }
#pragma unroll
    for (int i = 0; i < 16; ++i) { const int kk = 4 * i + kr; f32x4 v = vv[i];
        if (g) v = v * g[k0 + kk];
        scr[kk * 65 + c4] = v[0]; scr[kk * 65 + c4 + 1] = v[1]; scr[kk * 65 + c4 + 2] = v[2]; scr[kk * 65 + c4 + 3] = v[3]; }
    asm volatile("s_waitcnt lgkmcnt(0)" ::: "memory");
    const int c = lane & 7;
#pragma unroll
    for (int j = 0; j < 8; ++j) { const int n = (lane >> 3) + 8 * j; const LAS float* sp = scr + (8 * c) * 65 + n;
        u32x4 o; o.x = cvt_pk_bf16(sp[0], sp[65]); o.y = cvt_pk_bf16(sp[2 * 65], sp[3 * 65]); o.z = cvt_pk_bf16(sp[4 * 65], sp[5 * 65]); o.w = cvt_pk_bf16(sp[6 * 65], sp[7 * 65]);
        *(u32x4*)(WT + (size_t)(n0 + n) * K + k0 + 8 * c) = o; }
    asm volatile("s_waitcnt lgkmcnt(0)" ::: "memory");
}
__device__ __forceinline__ float wave_sum(float v, int lane) {
#pragma unroll
    for (int o = 1; o < 64; o <<= 1) v += shx(v, o, lane);
    return v;
}


#define XB_TMO      128
#define XB_XCNT(j)  (256  + 64 * (j))
#define XB_XSUB(j)  (1280 + 64 * (j))
#define XB_XGEN(j)  (2304 + 64 * (j))
#define XB_TOP      3328
#define XB_TOPGEN   3392
#define XCD_BAR_WORDS 3456
#define XB_SPIN_CAP (1u << 22)
__device__ __forceinline__ unsigned xb_ld(unsigned* p)              { return __hip_atomic_load(p, __ATOMIC_RELAXED, __HIP_MEMORY_SCOPE_AGENT); }
__device__ __forceinline__ unsigned xb_add(unsigned* p, unsigned v) { return __hip_atomic_fetch_add(p, v, __ATOMIC_RELAXED, __HIP_MEMORY_SCOPE_AGENT); }
__device__ __forceinline__ unsigned xb_xcc_id() { return (unsigned)__builtin_amdgcn_s_getreg((3 << 11) | 20) & 0xFu; }
#define XB_SPIN(cond, bar) do { unsigned _sp = 0; while (cond) { __builtin_amdgcn_s_sleep(1); \
    if ((++_sp & 255u) == 0u) { if (xb_ld(&(bar)[XB_TMO])) break; if (_sp > XB_SPIN_CAP) { atomicAdd(&(bar)[XB_TMO], 1u); break; } } } } while (0)
__device__ __forceinline__ void xcd_barrier_complete(unsigned* bar, unsigned x, unsigned G, unsigned& nloc, unsigned& nx) {
    unsigned sum, cnt, mine, sp = 0u;
    for (;;) {
        sum = 0u; cnt = 0u; mine = 0u;
#pragma unroll
        for (unsigned j = 0; j < 16; ++j) { const unsigned cc = xb_ld(&bar[XB_XCNT(j)]); sum += cc; cnt += (cc > 0u) ? 1u : 0u; mine = (j == x) ? cc : mine; }
        if (sum == G) break;
        __builtin_amdgcn_s_sleep(1);
        if ((++sp & 255u) == 0u) { if (xb_ld(&bar[XB_TMO])) break; if (sp > XB_SPIN_CAP) { atomicAdd(&bar[XB_TMO], 1u); break; } }
    }
    nloc = mine > 0u ? mine : 1u; nx = cnt > 0u ? cnt : 1u;
}
__device__ __forceinline__ void xcd_barrier(unsigned* bar, volatile LAS unsigned* st, bool leader, unsigned G) {
    asm volatile("s_waitcnt vmcnt(0)" ::: "memory");
    __syncthreads();
    if (leader) {
        const unsigned x = xb_xcc_id();
        __builtin_amdgcn_s_waitcnt(0);
        unsigned nloc = st[0], nx = st[1];
        if (nloc == 0u) { xcd_barrier_complete(bar, x, G, nloc, nx); st[0] = nloc; st[1] = nx; }
        const unsigned old = xb_add(&bar[XB_XSUB(x)], 1u);
        const unsigned gen = old / nloc;
        if (old + 1u == (gen + 1u) * nloc) {
            __builtin_amdgcn_fence(__ATOMIC_RELEASE, "agent");
            asm volatile("s_waitcnt vmcnt(0)" ::: "memory");
            const unsigned og = xb_add(&bar[XB_TOP], 1u);
            const unsigned tg = og / nx;
            if (og + 1u == (tg + 1u) * nx) xb_add(&bar[XB_TOPGEN], 1u);
            else XB_SPIN(xb_ld(&bar[XB_TOPGEN]) == tg, bar);
            __builtin_amdgcn_fence(__ATOMIC_ACQUIRE, "agent");
            xb_add(&bar[XB_XGEN(x)], 1u);
            asm volatile("s_waitcnt vmcnt(0)" ::: "memory");
        } else {
            XB_SPIN(xb_ld(&bar[XB_XGEN(x)]) == gen, bar);
            __builtin_amdgcn_fence(__ATOMIC_ACQUIRE, "agent");
            asm volatile("s_waitcnt vmcnt(0)" ::: "memory");
        }
    }
    __syncthreads();
}

#ifndef PHM
#define PHM 0xFFFF
#endif
#define PH(k) ((PHM >> (k)) & 1)
#ifndef RPM
#define RPM 0
#endif
#define REPS(k) for (int rep_ = 0; rep_ < (((RPM) >> (k)) & 1) + 1; ++rep_)
#define WL (ws + WS_W + (size_t)l * SZ_LAYER)
__global__ void __launch_bounds__(512, 2) hybrid_fwd(Params p) {
    extern __shared__ __attribute__((aligned(16))) unsigned char lds_raw[];
    LAS unsigned char* lds = (LAS unsigned char*)lds_raw;
    cg::grid_group grid = cg::this_grid();
    const int G_blk = gridDim.x, c_blk = blockIdx.x;
    const int wave0 = __builtin_amdgcn_readfirstlane((int)threadIdx.x >> 6);
    if (threadIdx.x < 16) ((LAS unsigned*)(lds + LDS_BYTES - 64))[threadIdx.x] = 0u;
    __syncthreads();
#define PHB int c = c_blk, G = G_blk; asm volatile("" : "+s"(c), "+s"(G)); int tid = wave0 * 64 + (int)__builtin_amdgcn_mbcnt_hi(~0u, __builtin_amdgcn_mbcnt_lo(~0u, 0u)); asm volatile("" : "+v"(tid)); const int lane = tid & 63, wave = __builtin_amdgcn_readfirstlane(tid >> 6); unsigned char* ws = p.ws; asm volatile("" : "+s"(ws)); (void)lane; (void)wave;
#define ssq ((u64*)(ws + WS_SSQ))
#define H ((float*)(ws + WS_H))
#define HB ((bf16_t*)(ws + WS_HB))
#define PROJ ((bf16_t*)(ws + WS_PROJ))
#define GATES ((float*)(ws + WS_GATES))
#define VT ((bf16_t*)(ws + WS_VT))
#define O ((bf16_t*)(ws + WS_O))
#define QX ((bf16_t*)(ws + WS_QX))
#define XO ((bf16_t*)(ws + WS_XO))
#define KX ((bf16_t*)(ws + WS_KX))
#define VXT ((bf16_t*)(ws + WS_VXT))
#define MEMB ((bf16_t*)(ws + WS_MEMB))
#define U ((bf16_t*)(ws + WS_U))
#define ACT ((bf16_t*)(ws + WS_ACT))
#define KVB ((float*)(ws + WS_KVB))
#define DEC ((float*)(ws + WS_DEC))
#define CC ((float*)(ws + WS_C))
#define KNB ((unsigned*)(ws + WS_C + 512 * 1024))

    if (p.out == nullptr) grid.sync();
    if (wave0 == 0 && __builtin_amdgcn_mbcnt_hi(~0u, __builtin_amdgcn_mbcnt_lo(~0u, 0u)) == 0u) (void)xb_add((unsigned*)p.ws + XB_XCNT(xb_xcc_id()), 1u);
#define GSYNC do { const bool ldr_ = (wave0 == 0) && (__builtin_amdgcn_mbcnt_hi(~0u, __builtin_amdgcn_mbcnt_lo(~0u, 0u)) == 0u); \
        xcd_barrier((unsigned*)p.ws, (volatile LAS unsigned*)(lds + LDS_BYTES - 64), ldr_, (unsigned)G_blk); } while (0)


    if (PH(0)) REPS(0) { PHB
        LAS float* scr = (LAS float*)(lds + wave * 16640);
        const int gw = c * 8 + wave, NGW = G * 8;
        constexpr int I_IN = 32 * (NWIN / 64), I_OUT = 32 * 32, I_Q = 32 * 8, I_KV = 32 * 16, I_O = 8 * 32, I_UP = 32 * 176, I_DN = 88 * 32;
        constexpr int I_LAYER = I_IN + I_OUT + I_Q + I_KV + I_O + I_UP + I_DN;
        for (int it = gw; it < 4 * I_LAYER; it += NGW) {
            const int l = it / I_LAYER; int r = it % I_LAYER; unsigned char* wl = ws + WS_W + (size_t)l * SZ_LAYER;
            if (r < I_IN) { transpose_item<1>(p.w_in + (size_t)l * D_ * INC, D_, INC, NWIN, (bf16_t*)(WL + OF_WIN), p.norm_mix + l * D_, scr, r, lane); continue; } r -= I_IN;
            if (r < I_OUT) { transpose_item<0>(p.w_mix_out + (size_t)l * D_ * D_, D_, D_, D_, (bf16_t*)(WL + OF_WOUT), nullptr, scr, r, lane); continue; } r -= I_OUT;
            if (r < I_Q) { transpose_item<0>(p.wq_x + (size_t)l * D_ * 512, D_, 512, 512, (bf16_t*)(WL + OF_WQ), p.norm_xattn + l * D_, scr, r, lane); continue; } r -= I_Q;
            if (r < I_KV) { transpose_item<0>(p.wkv_x + (size_t)l * D_ * 1024, D_, 1024, 1024, (bf16_t*)(WL + OF_WKV), p.norm_mem + l * D_, scr, r, lane); continue; } r -= I_KV;
            if (r < I_O) { transpose_item<0>(p.wo_x + (size_t)l * 512 * D_, 512, D_, D_, (bf16_t*)(WL + OF_WO), nullptr, scr, r, lane); continue; } r -= I_O;
            if (r < I_UP) { transpose_item<2>(p.w_up + (size_t)l * D_ * 2 * FF_, D_, 2 * FF_, 2 * FF_, (bf16_t*)(WL + OF_WUP), p.norm_ffn + l * D_, scr, r, lane); continue; } r -= I_UP;
            transpose_item<0>(p.w_down + (size_t)l * FF_ * D_, FF_, D_, D_, (bf16_t*)(WL + OF_WDN), nullptr, scr, r, lane);
        }
        for (int mrow = gw; mrow < T_ + MEM_; mrow += NGW) {
            const bool ism = mrow >= T_; const float* src = ism ? p.mem + (size_t)(mrow - T_) * D_ : p.x + (size_t)mrow * D_;
            bf16_t* dst = ism ? MEMB + (size_t)(mrow - T_) * D_ : HB + (size_t)mrow * D_;
            f32x4 v[8]; float s = 0.f;
#pragma unroll
            for (int j = 0; j < 8; ++j) { v[j] = *(const f32x4*)(src + 256 * j + 4 * lane); s += (v[j][0] * v[j][0] + v[j][1] * v[j][1]) + (v[j][2] * v[j][2] + v[j][3] * v[j][3]); }
            s = wave_sum(s, lane);
            float sc = 1.f; if (ism) sc = rsqrtf(s * (1.f / D_) + EPS); else if (lane == 0) ssq[mrow] = (u64)__float2ull_rn(s * SSQ_SCALE);
#pragma unroll
            for (int j = 0; j < 8; ++j) { u32x2 w2; w2.x = cvt_pk_bf16(v[j][0] * sc, v[j][1] * sc); w2.y = cvt_pk_bf16(v[j][2] * sc, v[j][3] * sc); *(u32x2*)(dst + 256 * j + 4 * lane) = w2; }
        }
        for (int i = c * 512 + tid; i < 12 * T_; i += G * 512) ssq[T_ + i] = 0ull;
        if (c == 0 && tid < 16) KNB[tid] = 0u;
        if (c == 1) for (int i = tid; i < 2 * D_ / 2; i += 512) ((unsigned*)HB)[i - 2 * D_ / 2] = 0u;
    }
    GSYNC;
#pragma unroll 1
    for (int l = 0; l < L_; ++l) {
        if (PH(1)) REPS(1) { PHB
            SchedIn S{ws, l, (l == 0) ? 16 : 0, G, c};
            EpiB E;
            pg8::gemm_phase<EpiB, SchedIn>(lds, tid, D_, S, E);
        }
        GSYNC;
        if (PH(2)) REPS(2) { PHB
            for (int u = c; u < 4 + 512 + 64; u += G) {
                if (u < 4) {
                    const int hd = u; const float bf = p.b_fox_f[l * 4 + hd];
                    LAS float* wt = (LAS float*)lds;
                    float pre[16]; float run = 0.f;
#pragma unroll
                    for (int j = 0; j < 16; ++j) { run += logsig(GATES[(size_t)(tid * 16 + j) * 32 + hd] + bf); pre[j] = run; }
                    float xs = run;
#pragma unroll
                    for (int off = 1; off < 64; off <<= 1) { const float y = __int_as_float(__builtin_amdgcn_ds_bpermute((lane >= off ? lane - off : lane) << 2, __float_as_int(xs))); if (lane >= off) xs += y; }
                    if (lane == 63) wt[wave] = xs;
                    __syncthreads();
                    float base = 0.f;
#pragma unroll
                    for (int g = 0; g < 8; ++g) if (g < wave) base += wt[g];
                    const float excl = base + xs - run;
#pragma unroll
                    for (int j = 0; j < 16; ++j) CC[(size_t)hd * T_ + tid * 16 + j] = excl + pre[j];
                    __syncthreads();
                } else if (u < 516) {
                    const int v = u - 4; gla_unit<0>(lds, tid, p, l, v >> 7, v & 127);
                } else {
                    const int v = u - 516, hd = v >> 4, sl = v & 15; float mxn = 0.f;
#pragma unroll 4
                    for (int ps = 0; ps < 16; ++ps) {
                        const int key = sl * 512 + ps * 32 + (tid >> 4);
                        const u32x4 kk = *(const u32x4*)(PROJ + (size_t)key * NP + PJ_FK + hd * 128 + (tid & 15) * 8);
                        float q2 = bflo(kk.x) * bflo(kk.x) + bfhi(kk.x) * bfhi(kk.x) + bflo(kk.y) * bflo(kk.y) + bfhi(kk.y) * bfhi(kk.y) + bflo(kk.z) * bflo(kk.z) + bfhi(kk.z) * bfhi(kk.z) + bflo(kk.w) * bflo(kk.w) + bfhi(kk.w) * bfhi(kk.w);
                        q2 += shx(q2, 1, lane); q2 += shx(q2, 2, lane); q2 += shx(q2, 4, lane); q2 += shx(q2, 8, lane);
                        mxn = fmaxf(mxn, q2);
                    }
                    mxn = fmaxf(mxn, shx(mxn, 16, lane)); mxn = fmaxf(mxn, shx(mxn, 32, lane));
                    if (lane == 0) atomicMax(KNB + l * 4 + hd, __float_as_uint(mxn));
                }
            }
        }
        GSYNC;
        if (PH(3)) { PHB
            if (c < 128) {
                const int u = c;

                    const int qb = 31 - (u >> 2), hd = u & 3, tq0 = 256 * qb + 32 * wave, t_row = tq0 + (lane & 31);
                    attn_unit<0>(lds, tid, PROJ + (size_t)t_row * NP + PJ_FQ + hd * 128, PROJ + PJ_FK + hd * 128, NP, VT + (size_t)(VT_F + hd * 128) * T_, T_,
                                 0, 4 * (qb + 1), t_row, tq0, CC + (size_t)hd * T_, NEG, 0.f, nullptr, O + (size_t)t_row * D_ + hd * 128, sqrtf(__uint_as_float(KNB[l * 4 + hd])));
            } else {
                const int cc = c - 128;
                LAS float* t5 = (LAS float*)(lds + AT_T5);
            for (int i = tid; i < 1024; i += 512) { const int hd = i >> 7, n = i & 127;
                int bk = n; if (n >= 16) { bk = 16 + (int)(__logf((float)n / 16.f) / __logf(8.f) * 16.f); bk = bk < 31 ? bk : 31; }
                t5[i] = p.t5_bias[bk * 8 + hd] * LOG2E; }
            __syncthreads();
                if (cc < 64) {
                    const int u = cc + 128;
                    const int v = u - 128, hh = v >> 4, e = (v & 15) * 512 + tid, dk = tid & 63;
                    float* kp = KVB + (size_t)hh * 128 * 8192 + e; const float* dp = DEC + (size_t)hh * 128 * 64 + dk;
                    float S = 0.f;
                    for (int n0 = 0; n0 < 128; n0 += 32) {
                        float kvv[32], dd[32];
#pragma unroll
                        for (int j = 0; j < 32; ++j) { kvv[j] = kp[(size_t)(n0 + j) * 8192]; dd[j] = dp[(n0 + j) * 64]; }
#pragma unroll
                        for (int j = 0; j < 32; ++j) { kp[(size_t)(n0 + j) * 8192] = S; S = dd[j] * S + kvv[j]; }
                    }
                }
                for (int si = 0; si < (cc < 64 ? 1 : 3); ++si) {
                    const int su = cc < 64 ? cc : 64 + (cc - 64) * 3 + si;
                    const int v = su, kvh = v >> 7, n = (v >> 1) & 63, pr = v & 1;
                    const int hl = wave >> 2, qh = kvh * 4 + pr * 2 + hl, tq0 = 128 * n + 32 * (wave & 3), t_row = tq0 + (lane & 31);
                    attn_unit<1>(lds, tid, PROJ + (size_t)t_row * NP + PJ_SQ + qh * 128, PROJ + PJ_SK + kvh * 128, NP, VT + (size_t)(VT_S + kvh * 128) * T_, T_,
                                 (2 * n - 2) < 0 ? 0 : (2 * n - 2), 2 * n + 2, t_row, tq0, nullptr, p.swa_sinks[l * 8 + qh] * LOG2E, 1.f, t5 + qh * 128,
                                 O + (size_t)t_row * D_ + 512 + qh * 128);
                }
            }
        }
        GSYNC;
        if (PH(4)) REPS(4) { PHB for (int u = c; u < 512; u += G) gla_unit<1>(lds, tid, p, l, u >> 7, u & 127); }
        GSYNC;
        if (PH(5)) { PHB
            SchedR S{(const char*)O, (const char*)(WL + OF_WOUT), D_, G, c};
            EpiR E{HB, ssq + (3 * l + 1) * T_, (LAS float*)(lds + 131072)};
            pg8::gemm_phase<EpiR, SchedR>(lds, tid, D_, S, E);
        }
        GSYNC;
        if (PH(6)) REPS(6) { PHB
            SchedQH S{ws, l, G, c};
            EpiB E;
            pg8::gemm_phase<EpiB, SchedQH, false, true>(lds, tid, D_, S, E);
            if (c < 128) {
                asm volatile("s_waitcnt vmcnt(0)" ::: "memory"); __syncthreads();
                const int hd = c >> 5, qb = c & 31, tq0 = 256 * qb + 32 * wave, t_row = tq0 + (lane & 31);
                attn_unit<2>(lds, tid, QX + (size_t)t_row * 512 + hd * 128, KX + (size_t)l * 256 * 512 + hd * 128, 512, VXT + (size_t)l * 512 * 256 + (size_t)hd * 128 * 256, 256,
                             0, 4, t_row, tq0, nullptr, NEG, 0.f, nullptr, XO + (size_t)t_row * 512 + hd * 128);
            }
        }
        GSYNC;
        if (PH(8)) { PHB
            SchedR S{(const char*)XO, (const char*)(WL + OF_WO), 512, G, c};
            EpiR E{HB, ssq + (3 * l + 2) * T_, (LAS float*)(lds + 131072)};
            pg8::gemm_phase<EpiR, SchedR>(lds, tid, 512, S, E);
        }
        GSYNC;
        if (PH(9)) REPS(9) { PHB
            SchedUp S{ws, l, G, c};
            EpiC E{p, ws, l, (LAS float*)(lds + 131072)};
            pg8::gemm_phase<EpiC, SchedUp, true>(lds, tid, D_, S, E);
        }
        GSYNC;
        if (PH(11)) { PHB
            SchedR S{(const char*)ACT, (const char*)(WL + OF_WDN), FF_, G, c};
            EpiR E{HB, ssq + (3 * l + 3) * T_, (LAS float*)(lds + 131072)};
            pg8::gemm_phase<EpiR, SchedR>(lds, tid, FF_, S, E);
        }
        GSYNC;
    }
    if (PH(12)) { PHB
        const u64* sq = ssq + 12 * T_;
        for (int row = c * 8 + wave; row < T_; row += G * 8) {
            const float rs = rsqrtf(u64f(sq[row]) * SSQ_INV + EPS);
#pragma unroll
            for (int j = 0; j < 8; ++j) { const u32x2 hv = *(const u32x2*)(HB + (size_t)row * D_ + 256 * j + 4 * lane); const f32x4 g = *(const f32x4*)(p.final_norm + 256 * j + 4 * lane);
                *(f32x4*)(p.out + (size_t)row * D_ + 256 * j + 4 * lane) = (f32x4){bflo(hv.x), bfhi(hv.x), bflo(hv.y), bfhi(hv.y)} * rs * g; }
        }
    }
}

extern "C" void kernel_launch(void* const* d_in, const int* in_sizes, int n_in, void* d_out, int out_size, void* d_ws, size_t ws_size, hipStream_t stream) {
    static int grid = 0;
    if (grid == 0) {
        if (n_in != 22 || ws_size < WS_END) { fprintf(stderr, "kernel_launch: unexpected n_in %d or ws_size %zu (< %zu)\n", n_in, ws_size, (size_t)WS_END); grid = -1; return; }
        int dev = 0, cus = 0, per_cu = 0;
        hipGetDevice(&dev); hipDeviceGetAttribute(&cus, hipDeviceAttributeMultiprocessorCount, dev);
        if (hipFuncSetAttribute((const void*)hybrid_fwd, hipFuncAttributeMaxDynamicSharedMemorySize, LDS_BYTES) != hipSuccess) { fprintf(stderr, "kernel_launch: hipFuncSetAttribute failed\n"); grid = -1; return; }
        hipOccupancyMaxActiveBlocksPerMultiprocessor(&per_cu, (const void*)hybrid_fwd, 512, LDS_BYTES);
        (void)hipGetLastError();
        if (per_cu < 1) { fprintf(stderr, "kernel_launch: occupancy query says %d\n", per_cu); per_cu = 1; }
        grid = cus * per_cu;
    }
    if (grid < 0) return;
    Params p{};
    const float** pp = (const float**)&p;
    for (int i = 0; i < 22; ++i) pp[i] = (const float*)d_in[i];
    p.out = (float*)d_out; p.ws = (unsigned char*)d_ws;
    if (hipMemsetAsync(d_ws, 0, 16384, stream) != hipSuccess) { fprintf(stderr, "kernel_launch: hipMemsetAsync of the barrier words failed\n"); return; }
    void* args[] = {&p};
    hipError_t e = hipLaunchCooperativeKernel((const void*)hybrid_fwd, dim3(grid), dim3(512), args, LDS_BYTES, stream);
    if (e != hipSuccess) fprintf(stderr, "cooperative launch failed: %s (grid %d)\n", hipGetErrorString(e), grid);
}
```

```cpp
#include <hip/hip_runtime.h>
#include <hip/hip_cooperative_groups.h>
#include <cstdio>
#include <cstdint>
namespace cg = cooperative_groups;

#define LAS __attribute__((address_space(3)))
typedef unsigned short bf16_t;
typedef short bf16x8 __attribute__((ext_vector_type(8)));
typedef float f32x4 __attribute__((ext_vector_type(4)));
typedef float f32x16 __attribute__((ext_vector_type(16)));
typedef unsigned u32x4 __attribute__((ext_vector_type(4)));
typedef unsigned u32x2 __attribute__((ext_vector_type(2)));

constexpr int T_ = 8192, D_ = 2048, L_ = 4, FF_ = 5632, INC = 4628, MEM_ = 256;
constexpr int NP = 3584;
constexpr int PJ_FQ = 0, PJ_FK = 512, PJ_SQ = 1024, PJ_SK = 2048, PJ_GQ = 2304, PJ_GK = 2560, PJ_GR = 2816, PJ_GT = 3328;
constexpr int VT_F = 0, VT_S = 512, VT_G = 768, NVT = 1280;
constexpr int NWIN = NP + NVT;
constexpr float EPS = 1e-6f, LOG2E = 1.4426950408889634f;
constexpr float NEG = -1e30f;

constexpr size_t MiB = 1ull << 20;
constexpr size_t SZ_WIN = (size_t)NWIN * D_ * 2, SZ_WOUT = (size_t)D_ * D_ * 2, SZ_WQ = 512ull * D_ * 2, SZ_WKV = 1024ull * D_ * 2,
                 SZ_WO = (size_t)D_ * 512 * 2, SZ_WUP = 2ull * FF_ * D_ * 2, SZ_WDN = (size_t)D_ * FF_ * 2;
constexpr size_t OF_WIN = 0, OF_WOUT = OF_WIN + SZ_WIN, OF_WQ = OF_WOUT + SZ_WOUT, OF_WKV = OF_WQ + SZ_WQ, OF_WO = OF_WKV + SZ_WKV,
                 OF_WUP = OF_WO + SZ_WO, OF_WDN = OF_WUP + SZ_WUP, SZ_LAYER = OF_WDN + SZ_WDN;
constexpr size_t WS_SSQ = 1 * MiB;
constexpr size_t WS_W = 2 * MiB;
constexpr size_t WS_H = WS_W + ((4 * SZ_LAYER + MiB - 1) / MiB) * MiB;
constexpr size_t WS_HB = WS_H + 64 * MiB;
constexpr size_t WS_PROJ = WS_HB + 32 * MiB;
constexpr size_t WS_GATES = WS_PROJ + 56 * MiB;
constexpr size_t WS_VT = WS_GATES + 1 * MiB;
constexpr size_t WS_O = WS_VT + 20 * MiB;
constexpr size_t WS_QX = WS_O + 32 * MiB;
constexpr size_t WS_XO = WS_QX + 8 * MiB;
constexpr size_t WS_KX = WS_XO + 8 * MiB;
constexpr size_t WS_VXT = WS_KX + 1 * MiB;
constexpr size_t WS_MEMB = WS_VXT + 1 * MiB;
constexpr size_t WS_U = WS_MEMB + 1 * MiB;
constexpr size_t WS_ACT = WS_U + 176 * MiB;
constexpr size_t WS_KVB = WS_ACT + 88 * MiB;
constexpr size_t WS_DEC = WS_KVB + 16 * MiB;
constexpr size_t WS_C = WS_DEC + 1 * MiB;
constexpr size_t WS_END = WS_C + 1 * MiB;

constexpr int LDS_BYTES = 147456;

struct Params {
    const float *x, *mem, *w_in, *b_fox_f, *swa_sinks, *t5_bias, *w_gla_gate, *b_gla_gate, *gla_norm, *w_mix_out, *norm_mix, *norm_xattn, *norm_mem,
        *wq_x, *wkv_x, *wo_x, *norm_ffn, *w_up, *conv_w, *conv_b, *w_down, *final_norm;
    float* out; unsigned char* ws;
};

__device__ __forceinline__ unsigned cvt_pk_bf16(float lo, float hi) { unsigned r; asm("v_cvt_pk_bf16_f32 %0, %1, %2" : "=v"(r) : "v"(lo), "v"(hi)); return r; }
__device__ __forceinline__ float bf2f(unsigned short b) { return __uint_as_float((unsigned)b << 16); }
__device__ __forceinline__ float bflo(unsigned w) { return __uint_as_float(w << 16); }
__device__ __forceinline__ float bfhi(unsigned w) { return __uint_as_float(w & 0xffff0000u); }
__device__ __forceinline__ float logsig(float x) { return fminf(x, 0.f) - __logf(1.f + __expf(-fabsf(x))); }
__device__ __forceinline__ float ex2(float x) { return __builtin_amdgcn_exp2f(x); }
__device__ __forceinline__ bf16x8 pack8(float a0, float a1, float a2, float a3, float a4, float a5, float a6, float a7) {
    u32x4 w; w.x = cvt_pk_bf16(a0, a1); w.y = cvt_pk_bf16(a2, a3); w.z = cvt_pk_bf16(a4, a5); w.w = cvt_pk_bf16(a6, a7);
    return __builtin_bit_cast(bf16x8, w);
}
__device__ __forceinline__ float shx(float v, int off, int lane) { return __int_as_float(__builtin_amdgcn_ds_bpermute((lane ^ off) << 2, __float_as_int(v))); }
__device__ __forceinline__ float xmax(float v) { const auto r = __builtin_amdgcn_permlane32_swap(__float_as_uint(v), __float_as_uint(v), false, false); return fmaxf(__uint_as_float(r[0]), __uint_as_float(r[1])); }
__device__ __forceinline__ float xsum(float v) { const auto r = __builtin_amdgcn_permlane32_swap(__float_as_uint(v), __float_as_uint(v), false, false); return __uint_as_float(r[0]) + __uint_as_float(r[1]); }
#define MFMA32(a, b, c) __builtin_amdgcn_mfma_f32_32x32x16_bf16((a), (b), (c), 0, 0, 0)

struct AB { const char* A; const char* B; };
namespace pg8 {
constexpr int BM = 256, BK = 64, HALF = 128, HTB = HALF * BK * 2, STAGE_BYTES = 8 * HTB;
__host__ __device__ __forceinline__ int lds_byte(int r, int c) { const int st = (r >> 4) * 2 + (c >> 5), rr = r & 15, cc = c & 31, ob = rr * 64 + cc * 2; return st * 1024 + (ob ^ (((ob >> 9) & 1) << 5)); }
__host__ __device__ __forceinline__ void stage_rc(int b, int& R, int& C) { const int st = b / 1024, sb = b % 1024, swz = sb ^ (((sb >> 9) & 1) << 5); R = (st >> 1) * 16 + swz / 64; C = (st & 1) * 32 + (swz % 64) / 2; }
__host__ __device__ __forceinline__ int perm32(int rho) { const int n = rho >> 4, i = rho & 15; return 8 * (i >> 2) + 4 * n + (i & 3); }

template <class Epi, class Sched, bool APERM = false, bool HALFN = false>
__device__ __forceinline__ void gemm_phase(LAS unsigned char* lds, const int tid_in, const int K, const Sched& S, const Epi& E) {
    typedef typename Sched::Unit Unit;
    int tid = tid_in; asm volatile("" : "+v"(tid));
    const int wid = __builtin_amdgcn_readfirstlane(tid >> 6), lane = tid & 63, wr = wid >> 2, wc = wid & 3, fr = lane & 15, fq = lane >> 4;
    const int nt = K / BK;
    unsigned voffA[2], voffB[2];
#pragma unroll
    for (int i = 0; i < 2; ++i) { int R, C; stage_rc(tid * 16 + i * 8192, R, C); const int Rb = Epi::PERM ? ((R & ~31) + perm32(R & 31)) : R;
        const int Ra = APERM ? (128 * (R >> 6) + 8 * (R & 15) + ((R >> 4) & 3)) : R;
        voffA[i] = (unsigned)(Ra * K + C) * 2u; voffB[i] = (unsigned)(Rb * K + C) * 2u; }
    const size_t kstep = (size_t)(BK * 2);
    const size_t hstep = (size_t)HALF * K * 2;
    const size_t hstepA = APERM ? (size_t)4 * K * 2 : hstep;
    const unsigned ldsw = (unsigned)wid * 1024u;
    const int aoff = lds_byte(wr * 64 + fr, fq * 8), boff = lds_byte(wc * 32 + fr, fq * 8);
#define PG8_SA(b, h) (((b) * 2 + (h)) * HTB)
#define PG8_SB(b, h) ((4 + (b) * 2 + (h)) * HTB)
#define PG8_STAGE(bufoff, gbase, voff) do { _Pragma("unroll") for (int _i = 0; _i < 2; ++_i) \
        __builtin_amdgcn_global_load_lds((const unsigned*)((const char*)(gbase) + (voff)[_i]), (LAS unsigned*)(lds + (bufoff) + ldsw + _i * 8192), 16, 0, 0); } while (0)
#define PG8_LDA(dst, b, h) do { _Pragma("unroll") for (int m = 0; m < 4; ++m) _Pragma("unroll") for (int k = 0; k < 2; ++k) dst[m][k] = *(const LAS bf16x8*)(lds + PG8_SA(b, h) + aoff + m * 2048 + k * 1024); } while (0)
#define PG8_LDB(dst, b, h) do { _Pragma("unroll") for (int n = 0; n < 2; ++n) _Pragma("unroll") for (int k = 0; k < 2; ++k) dst[n][k] = *(const LAS bf16x8*)(lds + PG8_SB(b, h) + boff + n * 2048 + k * 1024); } while (0)
#define PG8_MMA(ai, bj, At, Bt) do { __builtin_amdgcn_s_setprio(1); _Pragma("unroll") for (int m = 0; m < 4; ++m) _Pragma("unroll") for (int n = 0; n < 2; ++n) _Pragma("unroll") for (int k = 0; k < 2; ++k) \
        acc[ai][bj][m][n] = __builtin_amdgcn_mfma_f32_16x16x32_bf16(Bt[n][k], At[m][k], acc[ai][bj][m][n], 0, 0, 0); __builtin_amdgcn_s_setprio(0); } while (0)
#define PG8_WAIT_V(n) asm volatile("s_waitcnt vmcnt(" #n ")" ::: "memory")
#define PG8_WAIT_L(n) asm volatile("s_waitcnt lgkmcnt(" #n ")" ::: "memory")
#define PG8_BAR __builtin_amdgcn_s_barrier()
#define PG8_SCHED __builtin_amdgcn_sched_barrier(0)
    AB cur, nxt; int ui = 0;
    if (!S.next(0, cur)) return;
    f32x4 acc[2][2][4][2];
#pragma unroll
    for (int a = 0; a < 2; ++a)
#pragma unroll
        for (int b = 0; b < 2; ++b)
#pragma unroll
            for (int m = 0; m < 4; ++m)
#pragma unroll
                for (int n = 0; n < 2; ++n) acc[a][b][m][n] = (f32x4){0.f, 0.f, 0.f, 0.f};
    bf16x8 At[4][2], B0[2][2], B1[2][2];
    const char* cA = cur.A; const char* cB = cur.B;
    PG8_STAGE(PG8_SB(0, 0), cB, voffB); PG8_STAGE(PG8_SB(0, 1), cB + hstep, voffB); PG8_STAGE(PG8_SA(0, 0), cA, voffA); PG8_STAGE(PG8_SA(0, 1), cA + hstepA, voffA);
    if (wr == 1) PG8_BAR;
    PG8_WAIT_V(2); PG8_BAR;
    PG8_STAGE(PG8_SB(1, 0), cB + kstep, voffB); PG8_STAGE(PG8_SA(1, 0), cA + kstep, voffA); PG8_STAGE(PG8_SB(1, 1), cB + hstep + kstep, voffB);
    PG8_WAIT_V(6); PG8_BAR;
    for (;;) {
        const bool has_next = S.next(ui + 1, nxt);
        const char* nA = has_next ? nxt.A : cA; const char* nB = has_next ? nxt.B : cB;
        for (int t = 0; t < nt; t += 2) {
            const bool last = (t == nt - 2);
            const char* a1 = cA + (size_t)(t + 1) * kstep;
            const char* a2 = last ? nA : cA + (size_t)(t + 2) * kstep; const char* b2 = last ? nB : cB + (size_t)(t + 2) * kstep;
            const char* a3 = a2 + kstep; const char* b3 = b2 + kstep;
            PG8_LDB(B0, 0, 0); PG8_LDB(B1, 0, 1); PG8_SCHED; PG8_LDA(At, 0, 0); PG8_STAGE(PG8_SA(1, 1), a1 + hstepA, voffA);
            PG8_WAIT_V(8); PG8_WAIT_L(0); PG8_BAR; PG8_MMA(0, 0, At, B0); if constexpr (!HALFN) PG8_MMA(0, 1, At, B1); PG8_BAR; PG8_SCHED;
            PG8_LDA(At, 0, 1); PG8_STAGE(PG8_SB(0, 0), b2, voffB); PG8_STAGE(PG8_SB(0, 1), b2 + hstep, voffB); PG8_STAGE(PG8_SA(0, 0), a2, voffA);
            PG8_WAIT_V(8); PG8_WAIT_L(0); PG8_BAR; PG8_MMA(1, 0, At, B0); if constexpr (!HALFN) PG8_MMA(1, 1, At, B1); PG8_BAR; PG8_SCHED;
            PG8_LDB(B0, 1, 0); PG8_LDB(B1, 1, 1); PG8_SCHED; PG8_LDA(At, 1, 0); PG8_STAGE(PG8_SA(0, 1), a2 + hstepA, voffA);
            PG8_WAIT_V(8); PG8_WAIT_L(0); PG8_BAR; PG8_MMA(0, 0, At, B0); if constexpr (!HALFN) PG8_MMA(0, 1, At, B1); PG8_BAR; PG8_SCHED;
            PG8_LDA(At, 1, 1); PG8_STAGE(PG8_SB(1, 0), b3, voffB); PG8_STAGE(PG8_SB(1, 1), b3 + hstep, voffB); PG8_STAGE(PG8_SA(1, 0), a3, voffA);
            PG8_WAIT_V(8); PG8_WAIT_L(0); PG8_BAR; PG8_MMA(1, 0, At, B0); if constexpr (!HALFN) PG8_MMA(1, 1, At, B1); PG8_BAR; PG8_SCHED;
        }
        if (wr == 0) PG8_BAR;
        { const Unit fu = S.full(ui); E(acc, fu, wr, wc, fr, fq); }
        if (!has_next) break;
#pragma unroll
        for (int a = 0; a < 2; ++a)
#pragma unroll
            for (int b = 0; b < 2; ++b)
#pragma unroll
                for (int m = 0; m < 4; ++m)
#pragma unroll
                    for (int n = 0; n < 2; ++n) acc[a][b][m][n] = (f32x4){0.f, 0.f, 0.f, 0.f};
        cur = nxt; cA = nA; cB = nB; ++ui;
        if (wr == 1) PG8_BAR;
    }
    PG8_WAIT_V(0);
    PG8_BAR;
#undef PG8_SA
#undef PG8_SB
#undef PG8_STAGE
#undef PG8_LDA
#undef PG8_LDB
#undef PG8_MMA
#undef PG8_WAIT_V
#undef PG8_WAIT_L
#undef PG8_BAR
#undef PG8_SCHED
}
}

typedef unsigned long long u64;
constexpr float SSQ_SCALE = 16777216.f, SSQ_INV = 1.f / (16777216.f * 2048.f);
__device__ __forceinline__ float u64f(u64 q) { return (float)(unsigned)(q >> 32) * 4294967296.f + (float)(unsigned)q; }
struct GU { bf16_t* out; const u64* sc; float* gates; int ldc; int mode; };

struct EpiB {
    static constexpr bool PERM = true;
    __device__ __forceinline__ void operator()(const f32x4 (&acc)[2][2][4][2], const GU& u, int wr, int wc, int fr, int fq) const {
        const int r0 = wr * 64 + fr, c0 = wc * 32 + 8 * fq;
        f32x4 cs[2][2];
#pragma unroll
        for (int bj = 0; bj < 2; ++bj)
#pragma unroll
            for (int n = 0; n < 2; ++n) {
                if ((u.mode & 3) == 2) { const u64* q = u.sc + c0 + bj * 128 + 4 * n;
                    cs[bj][n] = (f32x4){rsqrtf(u64f(q[0]) * SSQ_INV + EPS), rsqrtf(u64f(q[1]) * SSQ_INV + EPS), rsqrtf(u64f(q[2]) * SSQ_INV + EPS), rsqrtf(u64f(q[3]) * SSQ_INV + EPS)}; }
                else cs[bj][n] = (f32x4){1.f, 1.f, 1.f, 1.f};
            }
        float rsv[2][4];
        if ((u.mode & 3) == 1) { u64 q_[2][4];
#pragma unroll
            for (int ai = 0; ai < 2; ++ai)
#pragma unroll
                for (int m = 0; m < 4; ++m) q_[ai][m] = u.sc[r0 + ai * 128 + m * 16];
#pragma unroll
            for (int ai = 0; ai < 2; ++ai)
#pragma unroll
                for (int m = 0; m < 4; ++m) rsv[ai][m] = rsqrtf(u64f(q_[ai][m]) * SSQ_INV + EPS);
        } else {
#pragma unroll
            for (int ai = 0; ai < 2; ++ai)
#pragma unroll
                for (int m = 0; m < 4; ++m) rsv[ai][m] = 1.f;
        }
#pragma unroll
        for (int ai = 0; ai < 2; ++ai)
#pragma unroll
            for (int m = 0; m < 4; ++m) {
                const int row = r0 + ai * 128 + m * 16;
                const float rs = rsv[ai][m];
                bf16_t* rowp = u.out + (size_t)row * u.ldc + c0;
#pragma unroll
                for (int bj = 0; bj < 2; ++bj) {
                    if (bj == 1 && (u.mode & 8)) continue;
                    f32x4 v0 = acc[ai][bj][m][0] * cs[bj][0] * rs, v1 = acc[ai][bj][m][1] * cs[bj][1] * rs;
                    u32x4 w; w.x = cvt_pk_bf16(v0[0], v0[1]); w.y = cvt_pk_bf16(v0[2], v0[3]); w.z = cvt_pk_bf16(v1[0], v1[1]); w.w = cvt_pk_bf16(v1[2], v1[3]);
                    *(u32x4*)(rowp + bj * 128) = w;
                    if (bj == 0 && u.gates != nullptr && wc == 0) { float* gp = u.gates + (size_t)row * 32 + 8 * fq; *(f32x4*)gp = v0; *(f32x4*)(gp + 4) = v1; }
                }
            }
    }
};

__device__ __forceinline__ void tile_order(int wgid, int nM, int nN, int& pm, int& pn) {
    const int nwg = nM * nN; { const int q = nwg / 8, r = nwg % 8, xcd = wgid % 8, off = wgid / 8; wgid = (xcd < r ? xcd * (q + 1) : r * (q + 1) + (xcd - r) * q) + off; }
    const int nig = 8 * nN, gid = wgid / nig, fm = gid * 8, gsz = (nM - fm) < 8 ? (nM - fm) : 8;
    pm = fm + ((wgid % nig) % gsz); pn = (wgid % nig) / gsz;
}

struct SchedIn {
    typedef GU Unit;
    unsigned char* ws; int l, nkv, G, c;
    __device__ __forceinline__ bool next(int i, AB& u) const {
        int Lx = i * G + c;
        const char* hb = (const char*)(ws + WS_HB); const char* wt = (const char*)(ws + WS_W + (size_t)l * SZ_LAYER + OF_WIN);
        if (Lx < 448) { int pm, pn; tile_order(Lx, 32, 14, pm, pn); u.A = hb + (size_t)pm * 256 * D_ * 2; u.B = wt + (size_t)pn * 256 * D_ * 2; return true; }
        Lx -= 448;
        if (Lx < 160) { const int pm = Lx % 5, pn = Lx / 5; u.A = wt + (size_t)(NP + pm * 256) * D_ * 2; u.B = hb + (size_t)pn * 256 * D_ * 2; return true; }
        Lx -= 160;
        if (Lx < nkv) { const int lk = Lx >> 2, j = Lx & 3; const char* w = (const char*)(ws + WS_W + OF_WKV + (size_t)lk * SZ_LAYER); const char* memb = (const char*)(ws + WS_MEMB);
            if (j < 2) { u.A = memb; u.B = w + (size_t)j * 256 * D_ * 2; } else { u.A = w + (size_t)(512 + (j - 2) * 256) * D_ * 2; u.B = memb; }
            return true; }
        return false;
    }
    __device__ __forceinline__ GU full(int i) const {
        GU u; int Lx = i * G + c; const u64* ssq = (const u64*)(ws + WS_SSQ) + (3 * l) * T_;
        if (Lx < 448) { int pm, pn; tile_order(Lx, 32, 14, pm, pn);
            u.out = (bf16_t*)(ws + WS_PROJ) + (size_t)pm * 256 * NP + pn * 256; u.sc = ssq + pm * 256;
            u.gates = (pn == 13) ? (float*)(ws + WS_GATES) + (size_t)pm * 256 * 32 : nullptr; u.ldc = NP; u.mode = 1; return u; }
        Lx -= 448;
        if (Lx < 160) { const int pm = Lx % 5, pn = Lx / 5;
            u.out = (bf16_t*)(ws + WS_VT) + (size_t)pm * 256 * T_ + pn * 256; u.sc = ssq + pn * 256; u.gates = nullptr; u.ldc = T_; u.mode = 2; return u; }
        Lx -= 160;
        { const int lk = Lx >> 2, j = Lx & 3; u.sc = nullptr; u.gates = nullptr; u.mode = 0;
            if (j < 2) { u.out = (bf16_t*)(ws + WS_KX) + (size_t)lk * 256 * 512 + j * 256; u.ldc = 512; }
            else { u.out = (bf16_t*)(ws + WS_VXT) + (size_t)lk * 512 * 256 + (size_t)(j - 2) * 256 * 256; u.ldc = 256; } }
        return u;
    }
};
struct SchedRow {
    typedef GU Unit;
    const char* A; const char* B; bf16_t* out; const u64* ssq; int nM, nN, K, G, c;
    __device__ __forceinline__ bool next(int i, AB& u) const {
        const int Lx = i * G + c; if (Lx >= nM * nN) return false;
        int pm, pn; tile_order(Lx, nM, nN, pm, pn);
        u.A = A + (size_t)pm * 256 * K * 2; u.B = B + (size_t)pn * 256 * K * 2; return true;
    }
    __device__ __forceinline__ GU full(int i) const {
        GU u; const int Lx = i * G + c; int pm, pn; tile_order(Lx, nM, nN, pm, pn);
        u.out = out + (size_t)pm * 256 * (nN * 256) + pn * 256; u.sc = ssq + pm * 256; u.gates = nullptr; u.ldc = nN * 256; u.mode = 1; return u;
    }
};
struct SchedQH {
    typedef GU Unit;
    unsigned char* ws; int l, G, c;
    __device__ __forceinline__ bool next(int i, AB& u) const {
        const int Lx = i * G + c; if (Lx >= 128) return false;
        u.A = (const char*)(ws + WS_HB) + (size_t)(Lx & 31) * 256 * D_ * 2; u.B = (const char*)(ws + WS_W + (size_t)l * SZ_LAYER + OF_WQ) + (size_t)(Lx >> 5) * 128 * D_ * 2; return true;
    }
    __device__ __forceinline__ GU full(int i) const { const int Lx = i * G + c, pm = Lx & 31, pq = Lx >> 5; GU u;
        u.out = (bf16_t*)(ws + WS_QX) + (size_t)pm * 256 * 512 + pq * 128; u.sc = (const u64*)(ws + WS_SSQ) + (3 * l + 1) * T_ + pm * 256; u.gates = nullptr; u.ldc = 512; u.mode = 1 | 8; return u; }
};
struct RU { int pm, pn; };
struct SchedR {
    typedef RU Unit;
    const char* A; const char* B; int K, G, c;
    __device__ __forceinline__ bool next(int i, AB& u) const {
        const int Lx = i * G + c; if (Lx >= 256) return false;
        u.A = A + (size_t)(Lx & 31) * 256 * K * 2; u.B = B + (size_t)(Lx >> 5) * 256 * K * 2; return true;
    }
    __device__ __forceinline__ RU full(int i) const { const int Lx = i * G + c; RU u; u.pm = Lx & 31; u.pn = Lx >> 5; return u; }
};
struct EpiR {
    static constexpr bool PERM = true;
    bf16_t* hb; u64* ssq; LAS float* red;
    __device__ __forceinline__ void operator()(const f32x4 (&acc)[2][2][4][2], const RU& u, int wr, int wc, int fr, int fq) const {
        const int col0 = u.pn * 256 + wc * 32 + 8 * fq, ln_ = fq * 16 + fr;
        u32x4 bb[2][4][2];
#pragma unroll
        for (int ai = 0; ai < 2; ++ai)
#pragma unroll
            for (int m = 0; m < 4; ++m) { const bf16_t* rp = hb + (size_t)(u.pm * 256 + ai * 128 + wr * 64 + m * 16 + fr) * D_ + col0; bb[ai][m][0] = *(const u32x4*)rp; bb[ai][m][1] = *(const u32x4*)(rp + 128); }
#pragma unroll
        for (int ai = 0; ai < 2; ++ai)
#pragma unroll
            for (int m = 0; m < 4; ++m) {
                const int row = u.pm * 256 + ai * 128 + wr * 64 + m * 16 + fr; float sq = 0.f;
                bf16_t* rp = hb + (size_t)row * D_ + col0;
#pragma unroll
                for (int bj = 0; bj < 2; ++bj) {
                    const u32x4 b = bb[ai][m][bj];
                    const f32x4 v0 = acc[ai][bj][m][0] + (f32x4){bflo(b.x), bfhi(b.x), bflo(b.y), bfhi(b.y)};
                    const f32x4 v1 = acc[ai][bj][m][1] + (f32x4){bflo(b.z), bfhi(b.z), bflo(b.w), bfhi(b.w)};
                    u32x4 w; w.x = cvt_pk_bf16(v0[0], v0[1]); w.y = cvt_pk_bf16(v0[2], v0[3]); w.z = cvt_pk_bf16(v1[0], v1[1]); w.w = cvt_pk_bf16(v1[2], v1[3]);
                    *(u32x4*)(rp + bj * 128) = w;
                    sq += ((v0[0] * v0[0] + v0[1] * v0[1]) + (v0[2] * v0[2] + v0[3] * v0[3])) + ((v1[0] * v1[0] + v1[1] * v1[1]) + (v1[2] * v1[2] + v1[3] * v1[3]));
                }
                sq += shx(sq, 16, ln_); sq += shx(sq, 32, ln_);
                if (fq == 0) red[wc * 256 + ai * 128 + wr * 64 + m * 16 + fr] = sq;
            }
        asm volatile("s_waitcnt lgkmcnt(0)" ::: "memory"); __builtin_amdgcn_s_barrier(); asm volatile("" ::: "memory");
        { const int t_ = (wr * 4 + wc) * 64 + ln_;
          if (t_ < 256) atomicAdd(ssq + u.pm * 256 + t_, (u64)__float2ull_rn(((red[t_] + red[256 + t_]) + (red[512 + t_] + red[768 + t_])) * SSQ_SCALE)); }
    }
};


struct CU2 { int pm, pn; };
struct SchedUp {
    typedef CU2 Unit;
    unsigned char* ws; int l, G, c;
    __device__ __forceinline__ bool next(int i, AB& u) const {
        const int Lx = i * G + c; if (Lx >= 33 * 44) return false;
        int pm, pn; tile_order(Lx, 33, 44, pm, pn);
        u.A = (const char*)(ws + WS_HB) + ((long)pm * 254 - 2) * (D_ * 2); u.B = (const char*)(ws + WS_W + (size_t)l * SZ_LAYER + OF_WUP) + (size_t)pn * 256 * D_ * 2; return true;
    }
    __device__ __forceinline__ CU2 full(int i) const { const int Lx = i * G + c; CU2 u; tile_order(Lx, 33, 44, u.pm, u.pn); return u; }
};
__device__ __forceinline__ float dpp_ror1(float v) { return __int_as_float(__builtin_amdgcn_mov_dpp(__float_as_int(v), 0x121, 0xF, 0xF, true)); }
__device__ __forceinline__ float dpp_ror2(float v) { return __int_as_float(__builtin_amdgcn_mov_dpp(__float_as_int(v), 0x122, 0xF, 0xF, true)); }
struct EpiC {
    static constexpr bool PERM = true;
    const Params& p; unsigned char* ws; int l; LAS float* hal;
    __device__ __forceinline__ void operator()(const f32x4 (&acc)[2][2][4][2], const CU2& u, int wr, int wc, int fr_, int fq_) const {
        int ln0 = (int)__builtin_amdgcn_mbcnt_hi(~0u, __builtin_amdgcn_mbcnt_lo(~0u, 0u)); asm volatile("" : "+v"(ln0)); const int fr = ln0 & 15, fq = ln0 >> 4;
        int cl = 32 * wc + 8 * fq, rb = 128 * wr + 8 * fr; asm volatile("" : "+v"(cl), "+v"(rb));
        const int t0 = 254 * u.pm - 2, tb = t0 + rb;
        const u64* ssq = (const u64*)(ws + WS_SSQ) + (3 * l + 2) * T_; const float* cw = p.conv_w + (size_t)l * 3 * 2 * FF_; const float* cb = p.conv_b + (size_t)l * 2 * FF_; bf16_t* act = (bf16_t*)(ws + WS_ACT);
        float rsv[8];
        { u64 q_[8];
#pragma unroll
          for (int j = 0; j < 8; ++j) q_[j] = ssq[(unsigned)(tb + j) < (unsigned)T_ ? tb + j : 0];
#pragma unroll
          for (int j = 0; j < 8; ++j) rsv[j] = (unsigned)(tb + j) < (unsigned)T_ ? rsqrtf(u64f(q_[j]) * SSQ_INV + EPS) : 0.f; }
        if (wr == 0 && fr == 15) {
#pragma unroll
            for (int bj = 0; bj < 2; ++bj)
#pragma unroll
                for (int n = 0; n < 2; ++n) { *(LAS f32x4*)(hal + 128 * bj + cl + 4 * n) = acc[1][bj][2][n] * rsv[6]; *(LAS f32x4*)(hal + 256 + 128 * bj + cl + 4 * n) = acc[1][bj][3][n] * rsv[7]; }
        }
        asm volatile("s_waitcnt lgkmcnt(0)" ::: "memory"); __builtin_amdgcn_s_barrier(); asm volatile("" ::: "memory");
#pragma unroll
        for (int n = 0; n < 2; ++n) {
            const float* wp = cw + 128 * u.pn + cl + 4 * n; const float* bp = cb + 128 * u.pn + cl + 4 * n;
            const f32x4 g0 = *(const f32x4*)wp, g1 = *(const f32x4*)(wp + 2 * FF_), g2 = *(const f32x4*)(wp + 4 * FF_), gb = *(const f32x4*)bp;
            const f32x4 v0 = *(const f32x4*)(wp + FF_), v1 = *(const f32x4*)(wp + 3 * FF_), v2 = *(const f32x4*)(wp + 5 * FF_), vb = *(const f32x4*)(bp + FF_);
            f32x4 pg2 = acc[1][0][2][n] * rsv[6], pg1 = acc[1][0][3][n] * rsv[7], pv2 = acc[1][1][2][n] * rsv[6], pv1 = acc[1][1][3][n] * rsv[7];
#pragma unroll
            for (int e = 0; e < 4; ++e) {
                pg2[e] = __int_as_float(__builtin_amdgcn_mov_dpp(__float_as_int(pg2[e]), 0x111, 0xF, 0xF, true)); pg1[e] = __int_as_float(__builtin_amdgcn_mov_dpp(__float_as_int(pg1[e]), 0x111, 0xF, 0xF, true));
                pv2[e] = __int_as_float(__builtin_amdgcn_mov_dpp(__float_as_int(pv2[e]), 0x111, 0xF, 0xF, true)); pv1[e] = __int_as_float(__builtin_amdgcn_mov_dpp(__float_as_int(pv1[e]), 0x111, 0xF, 0xF, true));
            }
            if (fr == 0 && wr == 1) { pg2 = *(const LAS f32x4*)(hal + cl + 4 * n); pg1 = *(const LAS f32x4*)(hal + 256 + cl + 4 * n); pv2 = *(const LAS f32x4*)(hal + 128 + cl + 4 * n); pv1 = *(const LAS f32x4*)(hal + 384 + cl + 4 * n); }
#pragma unroll
            for (int j = 0; j < 8; ++j) {
                const f32x4 xg = acc[j >> 2][0][j & 3][n] * rsv[j], xv = acc[j >> 2][1][j & 3][n] * rsv[j];
                const f32x4 gc = gb + g2 * xg + g1 * pg1 + g0 * pg2, vc = vb + v2 * xv + v1 * pv1 + v0 * pv2;
                f32x4 sg;
#pragma unroll
                for (int e = 0; e < 4; ++e) sg[e] = __builtin_amdgcn_rcpf(1.f + __expf(-gc[e]));
                const f32x4 o4 = gc * sg * vc;
                pg2 = pg1; pg1 = xg; pv2 = pv1; pv1 = xv;
                if (rb + j >= 2 && tb + j < T_) { u32x2 w; w.x = cvt_pk_bf16(o4[0], o4[1]); w.y = cvt_pk_bf16(o4[2], o4[3]); *(u32x2*)(act + (size_t)(tb + j) * FF_ + 128 * u.pn + cl + 4 * n) = w; }
                __builtin_amdgcn_sched_barrier(0);
            }
        }
    }
};

constexpr int AT_KROW = 272, AT_VROW = 144, AT_KBUF = 64 * AT_KROW, AT_VBUF = 128 * AT_VROW, AT_BUF = AT_KBUF + AT_VBUF + 256;
constexpr int AT_T5 = 73728;
template <int MODE>
__device__ __forceinline__ void attn_unit(LAS unsigned char* lds, const int tid_in, const bf16_t* Qrow, const bf16_t* Kb, int kpitch, const bf16_t* VTb, int vpitch, int kt0, int kt1,
                                          int t_row, int tq0, const float* cb, float m_init, float l_init, const LAS float* t5, bf16_t* Orow, float kn = 0.f) {
    int tid = tid_in; asm volatile("" : "+v"(tid));
    const int lane = tid & 63, r = lane & 31, hh = lane >> 5;
    constexpr float SC = 0.08838834764831845f * LOG2E;
    bf16x8 qf[8];
#pragma unroll
    for (int ks = 0; ks < 8; ++ks) qf[ks] = *(const bf16x8*)(Qrow + 16 * ks + 8 * hh);
    f32x16 o[4];
#pragma unroll
    for (int db = 0; db < 4; ++db)
#pragma unroll
        for (int i = 0; i < 16; ++i) o[db][i] = 0.f;
    float m = m_init, l = (hh == 0) ? l_init : 0.f;
    const int pr = (r & ~12) | ((r & 4) << 1) | ((r & 8) >> 1);
    const unsigned koff = pr * AT_KROW + 16 * hh, voff = AT_KBUF + r * AT_VROW + 16 * hh;
    const int kkey0 = tid >> 4, kc16 = tid & 15, vd0 = tid >> 3, vc8 = tid & 7;
    u32x4 kreg[2], vreg[2]; float creg = 0.f;
#define AT_LOAD(kt) do { const int k0_ = (kt) * 64; \
        kreg[0] = *(const u32x4*)(Kb + (size_t)(k0_ + kkey0) * kpitch + kc16 * 8); kreg[1] = *(const u32x4*)(Kb + (size_t)(k0_ + kkey0 + 32) * kpitch + kc16 * 8); \
        vreg[0] = *(const u32x4*)(VTb + (size_t)vd0 * vpitch + k0_ + vc8 * 8); vreg[1] = *(const u32x4*)(VTb + (size_t)(vd0 + 64) * vpitch + k0_ + vc8 * 8); \
        if (MODE == 0 && tid < 64) creg = cb[k0_ + tid]; } while (0)
#define AT_WRITE(b) do { LAS unsigned char* base_ = lds + (b) * AT_BUF; \
        *(LAS u32x4*)(base_ + kkey0 * AT_KROW + kc16 * 16) = kreg[0]; *(LAS u32x4*)(base_ + (kkey0 + 32) * AT_KROW + kc16 * 16) = kreg[1]; \
        *(LAS u32x4*)(base_ + AT_KBUF + vd0 * AT_VROW + vc8 * 16) = vreg[0]; *(LAS u32x4*)(base_ + AT_KBUF + (vd0 + 64) * AT_VROW + vc8 * 16) = vreg[1]; \
        if (MODE == 0 && tid < 64) *(LAS float*)(base_ + AT_KBUF + AT_VBUF + tid * 4) = -creg * LOG2E; } while (0)
    float qn = 0.f; bool wdone = false;
    LAS unsigned* flg = (LAS unsigned*)(lds + 2 * AT_BUF);
    if (MODE == 0) {
#pragma unroll
        for (int ks = 0; ks < 8; ++ks) { const u32x4 qq = __builtin_bit_cast(u32x4, qf[ks]);
            qn += bflo(qq.x) * bflo(qq.x) + bfhi(qq.x) * bfhi(qq.x) + bflo(qq.y) * bflo(qq.y) + bfhi(qq.y) * bfhi(qq.y) + bflo(qq.z) * bflo(qq.z) + bfhi(qq.z) * bfhi(qq.z) + bflo(qq.w) * bflo(qq.w) + bfhi(qq.w) * bfhi(qq.w); }
        qn = xsum(qn); qn = sqrtf(qn) * kn * SC * 1.0001f + 1e-3f;
    }
    AT_LOAD(kt1 - 1); AT_WRITE(0); __syncthreads();
#pragma unroll 1
    for (int kt = kt1 - 1; kt >= kt0; --kt) {
        const int cur = (kt1 - 1 - kt) & 1, k0 = kt * 64;
        if (kt > kt0) AT_LOAD(kt - 1);
        bool active = true;
        if (MODE == 0) active = (k0 <= tq0 + 31) && !wdone;
        if (MODE == 1) active = (k0 <= tq0 + 31) && (k0 + 63 > tq0 - 128);
        if (active) {
            const LAS unsigned char* base = lds + cur * AT_BUF;
            f32x16 s0, s1;
#pragma unroll
            for (int i = 0; i < 16; ++i) { s0[i] = 0.f; s1[i] = 0.f; }
            {
                bf16x8 ka[8];
#pragma unroll
                for (int ks = 0; ks < 8; ++ks) ka[ks] = *(const LAS bf16x8*)(base + koff + ks * 32);
                __builtin_amdgcn_sched_barrier(0);
#pragma unroll
                for (int ks = 0; ks < 8; ++ks) s0 = MFMA32(ka[ks], qf[ks], s0);
                __builtin_amdgcn_sched_barrier(0);
#pragma unroll
                for (int ks = 0; ks < 8; ++ks) ka[ks] = *(const LAS bf16x8*)(base + 32 * AT_KROW + koff + ks * 32);
                __builtin_amdgcn_sched_barrier(0);
#pragma unroll
                for (int ks = 0; ks < 8; ++ks) s1 = MFMA32(ka[ks], qf[ks], s1);
            }
            float x[32];
            const LAS float* cbl = (const LAS float*)(base + AT_KBUF + AT_VBUF);
            const bool need_mask = (MODE == 0) ? (k0 + 63 > tq0) : true;
            float mx = NEG;
            if (MODE == 1) {
#pragma unroll
                for (int i = 0; i < 32; ++i) { const int ii = i & 15, kl = 32 * (i >> 4) + (ii & 7) + 8 * hh + 16 * (ii >> 3); x[i] = t5[(t_row - (k0 + kl)) & 127]; }
                __builtin_amdgcn_sched_barrier(0);
            }
#pragma unroll
            for (int i = 0; i < 32; ++i) {
                const int blk = i >> 4, ii = i & 15, kl = 32 * blk + (ii & 7) + 8 * hh + 16 * (ii >> 3);
                float v = (blk ? s1[ii] : s0[ii]) * SC;
                if (MODE == 0) v += cbl[kl];
                if (MODE == 1) { const int rel = t_row - (k0 + kl); v = ((unsigned)rel < 128u) ? v + x[i] : NEG; }
                x[i] = v;
            }
            if (MODE == 0 && need_mask) {
#pragma unroll
                for (int i = 0; i < 32; ++i) { const int ii = i & 15, kl = 32 * (i >> 4) + (ii & 7) + 8 * hh + 16 * (ii >> 3); if (k0 + kl > t_row) x[i] = NEG; }
            }
#pragma unroll
            for (int i = 0; i < 32; ++i) mx = fmaxf(mx, x[i]);
            mx = xmax(mx);
            const float mn = fmaxf(m, mx), alpha = ex2(m - mn); m = mn;
            float rs = 0.f;
#pragma unroll
            for (int i = 0; i < 32; ++i) { x[i] = ex2(x[i] - mn); rs += x[i]; }
            l = l * alpha + rs;
#pragma unroll
            for (int db = 0; db < 4; ++db)
#pragma unroll
                for (int i = 0; i < 16; ++i) o[db][i] *= alpha;
            bf16x8 pf[4];
#pragma unroll
            for (int j = 0; j < 4; ++j) pf[j] = pack8(x[8 * j], x[8 * j + 1], x[8 * j + 2], x[8 * j + 3], x[8 * j + 4], x[8 * j + 5], x[8 * j + 6], x[8 * j + 7]);
#pragma unroll
            for (int jh = 0; jh < 2; ++jh) {
                bf16x8 va[2][4];
#pragma unroll
                for (int j = 0; j < 2; ++j)
#pragma unroll
                    for (int db = 0; db < 4; ++db) va[j][db] = *(const LAS bf16x8*)(base + voff + db * 32 * AT_VROW + (2 * jh + j) * 32);
                __builtin_amdgcn_sched_barrier(0);
#pragma unroll
                for (int j = 0; j < 2; ++j)
#pragma unroll
                    for (int db = 0; db < 4; ++db) o[db] = MFMA32(va[j][db], pf[2 * jh + j], o[db]);
                __builtin_amdgcn_sched_barrier(0);
            }
            if (MODE == 0 && kt > kt0 && k0 <= tq0) {
                const float ub = qn + cbl[0];
                wdone = __all(ub < m - 30.f);
            }
        }
        if (kt > kt0) AT_WRITE(cur ^ 1);
        if (MODE == 0) { if (lane == 0) flg[cur * 8 + (tid >> 6)] = wdone ? 0u : 1u; }
        __syncthreads();
        if (MODE == 0) { const u32x4 f0 = *(const LAS u32x4*)(flg + cur * 8), f1 = *(const LAS u32x4*)(flg + cur * 8 + 4);
            if (((f0.x | f0.y) | (f0.z | f0.w) | (f1.x | f1.y) | (f1.z | f1.w)) == 0u) break; }
    }
    if (MODE == 0) __syncthreads();
#undef AT_LOAD
#undef AT_WRITE
    l = xsum(l);
    const float inv = 1.f / l;
#pragma unroll
    for (int db = 0; db < 4; ++db)
#pragma unroll
        for (int g = 0; g < 4; g += 2) {
            unsigned ax = cvt_pk_bf16(o[db][4 * g] * inv, o[db][4 * g + 1] * inv), ay = cvt_pk_bf16(o[db][4 * g + 2] * inv, o[db][4 * g + 3] * inv);
            unsigned bx = cvt_pk_bf16(o[db][4 * g + 4] * inv, o[db][4 * g + 5] * inv), by = cvt_pk_bf16(o[db][4 * g + 6] * inv, o[db][4 * g + 7] * inv);
            const auto rx = __builtin_amdgcn_permlane32_swap(ax, bx, false, false), ry = __builtin_amdgcn_permlane32_swap(ay, by, false, false);
            u32x4 w; w.x = rx[0]; w.y = ry[0]; w.z = rx[1]; w.w = ry[1];
            *(u32x4*)(Orow + 32 * db + 8 * g + 8 * hh) = w;
        }
}

template <int MODEC>
__device__ __forceinline__ void gla_unit(LAS unsigned char* lds, const int tid_in, const Params& p, int l, int hh, int n) {
    int tid = tid_in; asm volatile("" : "+v"(tid));
    const int lane = tid & 63, w = __builtin_amdgcn_readfirstlane(tid >> 6), r = lane & 31, h2 = lane >> 5;
    unsigned char* ws = p.ws; asm volatile("" : "+s"(ws));
    const float* gates = (const float*)(ws + WS_GATES); const bf16_t* proj = (const bf16_t*)(ws + WS_PROJ); const bf16_t* vT = (const bf16_t*)(ws + WS_VT);
    float* kvb = (float*)(ws + WS_KVB); float* dec = (float*)(ws + WS_DEC);
    LAS float* bmat = (LAS float*)lds; LAS float* seg = (LAS float*)(lds + 16384); LAS float* blast = (LAS float*)(lds + 18432);
    LAS bf16_t* QT = (LAS bf16_t*)(lds + 18688); LAS bf16_t* KT = (LAS bf16_t*)(lds + 27904); LAS float* ss = (LAS float*)(lds + 37120);
    const int t0 = 64 * n;
    {
        const int d = lane; const float* wg = p.w_gla_gate + (size_t)l * 16 * 256 + hh * 64 + d; const float bgv = p.b_gla_gate[l * 256 + hh * 64 + d];
        float wgr[16];
#pragma unroll
        for (int q = 0; q < 16; ++q) wgr[q] = wg[q * 256];
        LAS float* gl = (LAS float*)(lds + 38400);
        if (tid < 256) *(LAS f32x4*)(gl + (tid >> 2) * 16 + (tid & 3) * 4) = *(const f32x4*)(gates + (size_t)(t0 + (tid >> 2)) * 32 + 4 + (tid & 3) * 4);
        __syncthreads();
        float pcs[8]; float run = 0.f;
#pragma unroll
        for (int j = 0; j < 8; ++j) { const LAS float* gp = gl + (w * 8 + j) * 16; float z = bgv;
#pragma unroll
            for (int q = 0; q < 16; ++q) z += gp[q] * wgr[q];
            run += logsig(z) * (1.f / 16.f); pcs[j] = run; }
        seg[w * 64 + d] = run; __syncthreads();
        float off = 0.f, tot = 0.f;
#pragma unroll
        for (int g = 0; g < 8; ++g) { const float sv = seg[g * 64 + d]; tot += sv; if (g < w) off += sv; }
#pragma unroll
        for (int j = 0; j < 8; ++j) bmat[(w * 8 + j) * 64 + d] = off + pcs[j];
        if (w == 0) blast[d] = tot;
        __syncthreads();
    }
    const int s = tid >> 3, dk8 = (tid & 7) * 8;
    if (MODEC == 0) {
        const u32x4 kk = *(const u32x4*)(proj + (size_t)(t0 + s) * NP + PJ_GK + hh * 64 + dk8);
        const unsigned kw[4] = {kk.x, kk.y, kk.z, kk.w};
#pragma unroll
        for (int j = 0; j < 8; ++j) { const float kf = ((j & 1) ? bfhi(kw[j >> 1]) : bflo(kw[j >> 1])) * __expf(blast[dk8 + j] - bmat[s * 64 + dk8 + j]);
            QT[(dk8 + j) * 72 + s] = (bf16_t)(cvt_pk_bf16(kf, 0.f) & 0xffffu); }
        if (tid < 64) dec[(size_t)(hh * 128 + n) * 64 + tid] = __expf(blast[tid]);
        __syncthreads();
        const int dvb = w & 3, dkb = w >> 2;
        f32x16 acc;
#pragma unroll
        for (int i = 0; i < 16; ++i) acc[i] = 0.f;
        bf16x8 va[4];
#pragma unroll
        for (int ks = 0; ks < 4; ++ks) va[ks] = *(const bf16x8*)(vT + (size_t)(VT_G + hh * 128 + 32 * dvb + r) * T_ + t0 + 16 * ks + 8 * h2);
#pragma unroll
        for (int ks = 0; ks < 4; ++ks) {
            const bf16x8 b = *(const LAS bf16x8*)(QT + (32 * dkb + r) * 72 + 16 * ks + 8 * h2);
            acc = MFMA32(va[ks], b, acc);
        }
        float* kp = kvb + (size_t)(hh * 128 + n) * 128 * 64 + 32 * dkb + r;
#pragma unroll
        for (int i = 0; i < 16; ++i) { const int dv = 32 * dvb + (i & 3) + 8 * (i >> 2) + 4 * h2; kp[(size_t)dv * 64] = acc[i]; }
        __syncthreads();
    } else {
        const u32x4 qq = *(const u32x4*)(proj + (size_t)(t0 + s) * NP + PJ_GQ + hh * 64 + dk8);
        const u32x4 kk = *(const u32x4*)(proj + (size_t)(t0 + s) * NP + PJ_GK + hh * 64 + dk8);
        const unsigned qw[4] = {qq.x, qq.y, qq.z, qq.w}, kw[4] = {kk.x, kk.y, kk.z, kk.w};
        float qv[8], kv[8];
#pragma unroll
        for (int j = 0; j < 8; ++j) { const float b = bmat[s * 64 + dk8 + j];
            qv[j] = ((j & 1) ? bfhi(qw[j >> 1]) : bflo(qw[j >> 1])) * 0.125f * __expf(b);
            kv[j] = ((j & 1) ? bfhi(kw[j >> 1]) : bflo(kw[j >> 1])) * __expf(-b); }
        *(LAS bf16x8*)(QT + s * 72 + dk8) = pack8(qv[0], qv[1], qv[2], qv[3], qv[4], qv[5], qv[6], qv[7]);
        *(LAS bf16x8*)(KT + s * 72 + dk8) = pack8(kv[0], kv[1], kv[2], kv[3], kv[4], kv[5], kv[6], kv[7]);
        __syncthreads();
        const int dvb = w & 3, tb = w >> 2, tt = 32 * tb + r;
        const int pr = (r & ~12) | ((r & 4) << 1) | ((r & 8) >> 1);
        bf16x8 qfr[4];
#pragma unroll
        for (int ks = 0; ks < 4; ++ks) qfr[ks] = *(const LAS bf16x8*)(QT + tt * 72 + 16 * ks + 8 * h2);
        f32x16 acc;
#pragma unroll
        for (int i = 0; i < 16; ++i) acc[i] = 0.f;
        bf16x8 vfr[2][2]; f32x4 sfr[4][2];
#pragma unroll
        for (int sb = 0; sb < 2; ++sb)
#pragma unroll
            for (int kk2 = 0; kk2 < 2; ++kk2) vfr[sb][kk2] = *(const bf16x8*)(vT + (size_t)(VT_G + hh * 128 + 32 * dvb + r) * T_ + t0 + 32 * sb + 16 * kk2 + 8 * h2);
        { const float* sp_ = kvb + ((size_t)(hh * 128 + n) * 128 + 32 * dvb + r) * 64 + 8 * h2;
#pragma unroll
          for (int ks = 0; ks < 4; ++ks) { sfr[ks][0] = *(const f32x4*)(sp_ + 16 * ks); sfr[ks][1] = *(const f32x4*)(sp_ + 16 * ks + 4); } }
#pragma unroll
        for (int sb = 0; sb < 2; ++sb) {
            if (sb <= tb) {
                f32x16 sa;
#pragma unroll
                for (int i = 0; i < 16; ++i) sa[i] = 0.f;
#pragma unroll
                for (int ks = 0; ks < 4; ++ks) { const bf16x8 a = *(const LAS bf16x8*)(KT + (32 * sb + pr) * 72 + 16 * ks + 8 * h2); sa = MFMA32(a, qfr[ks], sa); }
#pragma unroll
                for (int i = 0; i < 16; ++i) { const int sl = 32 * sb + (i & 7) + 8 * h2 + 16 * (i >> 3); if (sl > tt) sa[i] = 0.f; }
#pragma unroll
                for (int kk2 = 0; kk2 < 2; ++kk2) {
                    const bf16x8 pfr = pack8(sa[8 * kk2], sa[8 * kk2 + 1], sa[8 * kk2 + 2], sa[8 * kk2 + 3], sa[8 * kk2 + 4], sa[8 * kk2 + 5], sa[8 * kk2 + 6], sa[8 * kk2 + 7]);
                    acc = MFMA32(vfr[sb][kk2], pfr, acc);
                }
            }
        }
#pragma unroll
        for (int ks = 0; ks < 4; ++ks) {
            const f32x4 s0 = sfr[ks][0], s1 = sfr[ks][1];
            const bf16x8 a = pack8(s0[0], s0[1], s0[2], s0[3], s1[0], s1[1], s1[2], s1[3]);
            acc = MFMA32(a, qfr[ks], acc);
        }
        float part = 0.f;
#pragma unroll
        for (int i = 0; i < 16; ++i) part += acc[i] * acc[i];
        part += shx(part, 32, lane);
        if (h2 == 0) ss[tt * 4 + dvb] = part;
        __syncthreads();
        const float tot = (ss[tt * 4] + ss[tt * 4 + 1]) + (ss[tt * 4 + 2] + ss[tt * 4 + 3]);
        const float rstd = rsqrtf(tot * (1.f / 128.f) + EPS);
        bf16_t* op = (bf16_t*)(ws + WS_O) + (size_t)(t0 + tt) * D_ + 1536 + hh * 128;
        const bf16_t* grp = proj + (size_t)(t0 + tt) * NP + PJ_GR + hh * 128;
        const float* gn = p.gla_norm + l * 128;
#pragma unroll
        for (int g = 0; g < 4; ++g) {
            const int dv = 32 * dvb + 8 * g + 4 * h2;
            const u32x2 gw = *(const u32x2*)(grp + dv); const f32x4 gnv = *(const f32x4*)(gn + dv);
            const float g0 = bflo(gw.x), g1 = bfhi(gw.x), g2 = bflo(gw.y), g3 = bfhi(gw.y);
            const float v0 = acc[4 * g] * rstd * gnv[0] * (g0 * __builtin_amdgcn_rcpf(1.f + __expf(-g0))), v1 = acc[4 * g + 1] * rstd * gnv[1] * (g1 * __builtin_amdgcn_rcpf(1.f + __expf(-g1)));
            const float v2 = acc[4 * g + 2] * rstd * gnv[2] * (g2 * __builtin_amdgcn_rcpf(1.f + __expf(-g2))), v3 = acc[4 * g + 3] * rstd * gnv[3] * (g3 * __builtin_amdgcn_rcpf(1.f + __expf(-g3)));
            u32x2 wv; wv.x = cvt_pk_bf16(v0, v1); wv.y = cvt_pk_bf16(v2, v3); *(u32x2*)(op + dv) = wv;
        }
        __syncthreads();
    }
}

__device__ __forceinline__ int inmap(int nd) {
    if (nd < 1024) return nd;
    if (nd < 2048) return 1540 + nd - 1024;
    if (nd < 2304) return 2564 + nd - 2048;
    if (nd < 2560) return 3076 + nd - 2304;
    if (nd < 2816) return 3332 + nd - 2560;
    if (nd < 3328) return 4100 + nd - 2816;
    if (nd < 3332) return 1536 + nd - 3328;
    if (nd < 3348) return 4612 + nd - 3332;
    if (nd < 3584) return -1;
    if (nd < 4096) return 1024 + nd - 3584;
    if (nd < 4352) return 2820 + nd - 4096;
    return 3588 + nd - 4352;
}
__device__ __forceinline__ int upmap(int nd) { const int pn = nd >> 8, q = nd & 255; return q < 128 ? 128 * pn + q : FF_ + 128 * pn + (q - 128); }
template <int MAPK>
__device__ __forceinline__ void transpose_item(const float* W, int K, int N, int ND, bf16_t* WT, const float* g, LAS float* scr, int item, int lane) {
    const int nblk = ND / 64, kb = item / nblk, nb = item % nblk, k0 = 64 * kb, n0 = 64 * nb;
    const int c4 = (lane & 15) * 4, kr = lane >> 4;
    int src = n0 + c4; if (MAPK == 1) src = inmap(src); if (MAPK == 2) src = upmap(src);
    f32x4 vv[16];
#pragma unroll
    for (int i = 0; i < 16; ++i) { const int kk = 4 * i + kr;
        vv[i] = (f32x4){0.f, 0.f, 0.f, 0.f};
        if (src >= 0) vv[i] = *(const f32x4*)(W + (size_t)(k0 + kk) * N + src); }
#pragma unroll
    for (int i = 0; i < 16; ++i) { const int kk = 4 * i + kr; f32x4 v = vv[i];
        if (g) v = v * g[k0 + kk];
        scr[kk * 65 + c4] = v[0]; scr[kk * 65 + c4 + 1] = v[1]; scr[kk * 65 + c4 + 2] = v[2]; scr[kk * 65 + c4 + 3] = v[3]; }
    asm volatile("s_waitcnt lgkmcnt(0)" ::: "memory");
    const int c = lane & 7;
#pragma unroll
    for (int j = 0; j < 8; ++j) { const int n = (lane >> 3) + 8 * j; const LAS float* sp = scr + (8 * c) * 65 + n;
        u32x4 o; o.x = cvt_pk_bf16(sp[0], sp[65]); o.y = cvt_pk_bf16(sp[2 * 65], sp[3 * 65]); o.z = cvt_pk_bf16(sp[4 * 65], sp[5 * 65]); o.w = cvt_pk_bf16(sp[6 * 65], sp[7 * 65]);
        *(u32x4*)(WT + (size_t)(n0 + n) * K + k0 + 8 * c) = o; }
    asm volatile("s_waitcnt lgkmcnt(0)" ::: "memory");
}
__device__ __forceinline__ float wave_sum(float v, int lane) {
#pragma unroll
    for (int o = 1; o < 64; o <<= 1) v += shx(v, o, lane);
    return v;
}


#define XB_TMO      128
#define XB_XCNT(j)  (256  + 64 * (j))
#define XB_XSUB(j)  (1280 + 64 * (j))
#define XB_XGEN(j)  (2304 + 64 * (j))
#define XB_TOP      3328
#define XB_TOPGEN   3392
#define XCD_BAR_WORDS 3456
#define XB_SPIN_CAP (1u << 22)
__device__ __forceinline__ unsigned xb_ld(unsigned* p)              { return __hip_atomic_load(p, __ATOMIC_RELAXED, __HIP_MEMORY_SCOPE_AGENT); }
__device__ __forceinline__ unsigned xb_add(unsigned* p, unsigned v) { return __hip_atomic_fetch_add(p, v, __ATOMIC_RELAXED, __HIP_MEMORY_SCOPE_AGENT); }
__device__ __forceinline__ unsigned xb_xcc_id() { return (unsigned)__builtin_amdgcn_s_getreg((3 << 11) | 20) & 0xFu; }
#define XB_SPIN(cond, bar) do { unsigned _sp = 0; while (cond) { __builtin_amdgcn_s_sleep(1); \
    if ((++_sp & 255u) == 0u) { if (xb_ld(&(bar)[XB_TMO])) break; if (_sp > XB_SPIN_CAP) { atomicAdd(&(bar)[XB_TMO], 1u); break; } } } } while (0)
__device__ __forceinline__ void xcd_barrier_complete(unsigned* bar, unsigned x, unsigned G, unsigned& nloc, unsigned& nx) {
    unsigned sum, cnt, mine, sp = 0u;
    for (;;) {
        sum = 0u; cnt = 0u; mine = 0u;
#pragma unroll
        for (unsigned j = 0; j < 16; ++j) { const unsigned cc = xb_ld(&bar[XB_XCNT(j)]); sum += cc; cnt += (cc > 0u) ? 1u : 0u; mine = (j == x) ? cc : mine; }
        if (sum == G) break;
        __builtin_amdgcn_s_sleep(1);
        if ((++sp & 255u) == 0u) { if (xb_ld(&bar[XB_TMO])) break; if (sp > XB_SPIN_CAP) { atomicAdd(&bar[XB_TMO], 1u); break; } }
    }
    nloc = mine > 0u ? mine : 1u; nx = cnt > 0u ? cnt : 1u;
}
__device__ __forceinline__ void xcd_barrier(unsigned* bar, volatile LAS unsigned* st, bool leader, unsigned G) {
    asm volatile("s_waitcnt vmcnt(0)" ::: "memory");
    __syncthreads();
    if (leader) {
        const unsigned x = xb_xcc_id();
        __builtin_amdgcn_s_waitcnt(0);
        unsigned nloc = st[0], nx = st[1];
        if (nloc == 0u) { xcd_barrier_complete(bar, x, G, nloc, nx); st[0] = nloc; st[1] = nx; }
        const unsigned old = xb_add(&bar[XB_XSUB(x)], 1u);
        const unsigned gen = old / nloc;
        if (old + 1u == (gen + 1u) * nloc) {
            __builtin_amdgcn_fence(__ATOMIC_RELEASE, "agent");
            asm volatile("s_waitcnt vmcnt(0)" ::: "memory");
            const unsigned og = xb_add(&bar[XB_TOP], 1u);
            const unsigned tg = og / nx;
            if (og + 1u == (tg + 1u) * nx) xb_add(&bar[XB_TOPGEN], 1u);
            else XB_SPIN(xb_ld(&bar[XB_TOPGEN]) == tg, bar);
            __builtin_amdgcn_fence(__ATOMIC_ACQUIRE, "agent");
            xb_add(&bar[XB_XGEN(x)], 1u);
            asm volatile("s_waitcnt vmcnt(0)" ::: "memory");
        } else {
            XB_SPIN(xb_ld(&bar[XB_XGEN(x)]) == gen, bar);
            __builtin_amdgcn_fence(__ATOMIC_ACQUIRE, "agent");
            asm volatile("s_waitcnt vmcnt(0)" ::: "memory");
        }
    }
    __syncthreads();
}

#ifndef PHM
#define PHM 0xFFFF
#endif
#define PH(k) ((PHM >> (k)) & 1)
#ifndef RPM
#define RPM 0
#endif
#define REPS(k) for (int rep_ = 0; rep_ < (((RPM) >> (k)) & 1) + 1; ++rep_)
#define WL (ws + WS_W + (size_t)l * SZ_LAYER)
__global__ void __launch_bounds__(512, 2) hybrid_fwd(Params p) {
    extern __shared__ __attribute__((aligned(16))) unsigned char lds_raw[];
    LAS unsigned char* lds = (LAS unsigned char*)lds_raw;
    cg::grid_group grid = cg::this_grid();
    const int G_blk = gridDim.x, c_blk = blockIdx.x;
    const int wave0 = __builtin_amdgcn_readfirstlane((int)threadIdx.x >> 6);
    if (threadIdx.x < 16) ((LAS unsigned*)(lds + LDS_BYTES - 64))[threadIdx.x] = 0u;
    __syncthreads();
#define PHB int c = c_blk, G = G_blk; asm volatile("" : "+s"(c), "+s"(G)); int tid = wave0 * 64 + (int)__builtin_amdgcn_mbcnt_hi(~0u, __builtin_amdgcn_mbcnt_lo(~0u, 0u)); asm volatile("" : "+v"(tid)); const int lane = tid & 63, wave = __builtin_amdgcn_readfirstlane(tid >> 6); unsigned char* ws = p.ws; asm volatile("" : "+s"(ws)); (void)lane; (void)wave;
#define ssq ((u64*)(ws + WS_SSQ))
#define H ((float*)(ws + WS_H))
#define HB ((bf16_t*)(ws + WS_HB))
#define PROJ ((bf16_t*)(ws + WS_PROJ))
#define GATES ((float*)(ws + WS_GATES))
#define VT ((bf16_t*)(ws + WS_VT))
#define O ((bf16_t*)(ws + WS_O))
#define QX ((bf16_t*)(ws + WS_QX))
#define XO ((bf16_t*)(ws + WS_XO))
#define KX ((bf16_t*)(ws + WS_KX))
#define VXT ((bf16_t*)(ws + WS_VXT))
#define MEMB ((bf16_t*)(ws + WS_MEMB))
#define U ((bf16_t*)(ws + WS_U))
#define ACT ((bf16_t*)(ws + WS_ACT))
#define KVB ((float*)(ws + WS_KVB))
#define DEC ((float*)(ws + WS_DEC))
#define CC ((float*)(ws + WS_C))
#define KNB ((unsigned*)(ws + WS_C + 512 * 1024))

    if (p.out == nullptr) grid.sync();
    if (wave0 == 0 && __builtin_amdgcn_mbcnt_hi(~0u, __builtin_amdgcn_mbcnt_lo(~0u, 0u)) == 0u) (void)xb_add((unsigned*)p.ws + XB_XCNT(xb_xcc_id()), 1u);
#define GSYNC do { const bool ldr_ = (wave0 == 0) && (__builtin_amdgcn_mbcnt_hi(~0u, __builtin_amdgcn_mbcnt_lo(~0u, 0u)) == 0u); \
        xcd_barrier((unsigned*)p.ws, (volatile LAS unsigned*)(lds + LDS_BYTES - 64), ldr_, (unsigned)G_blk); } while (0)


    if (PH(0)) REPS(0) { PHB
        LAS float* scr = (LAS float*)(lds + wave * 16640);
        const int gw = c * 8 + wave, NGW = G * 8;
        constexpr int I_IN = 32 * (NWIN / 64), I_OUT = 32 * 32, I_Q = 32 * 8, I_KV = 32 * 16, I_O = 8 * 32, I_UP = 32 * 176, I_DN = 88 * 32;
        constexpr int I_LAYER = I_IN + I_OUT + I_Q + I_KV + I_O + I_UP + I_DN;
        for (int it = gw; it < 4 * I_LAYER; it += NGW) {
            const int l = it / I_LAYER; int r = it % I_LAYER; unsigned char* wl = ws + WS_W + (size_t)l * SZ_LAYER;
            if (r < I_IN) { transpose_item<1>(p.w_in + (size_t)l * D_ * INC, D_, INC, NWIN, (bf16_t*)(WL + OF_WIN), p.norm_mix + l * D_, scr, r, lane); continue; } r -= I_IN;
            if (r < I_OUT) { transpose_item<0>(p.w_mix_out + (size_t)l * D_ * D_, D_, D_, D_, (bf16_t*)(WL + OF_WOUT), nullptr, scr, r, lane); continue; } r -= I_OUT;
            if (r < I_Q) { transpose_item<0>(p.wq_x + (size_t)l * D_ * 512, D_, 512, 512, (bf16_t*)(WL + OF_WQ), p.norm_xattn + l * D_, scr, r, lane); continue; } r -= I_Q;
            if (r < I_KV) { transpose_item<0>(p.wkv_x + (size_t)l * D_ * 1024, D_, 1024, 1024, (bf16_t*)(WL + OF_WKV), p.norm_mem + l * D_, scr, r, lane); continue; } r -= I_KV;
            if (r < I_O) { transpose_item<0>(p.wo_x + (size_t)l * 512 * D_, 512, D_, D_, (bf16_t*)(WL + OF_WO), nullptr, scr, r, lane); continue; } r -= I_O;
            if (r < I_UP) { transpose_item<2>(p.w_up + (size_t)l * D_ * 2 * FF_, D_, 2 * FF_, 2 * FF_, (bf16_t*)(WL + OF_WUP), p.norm_ffn + l * D_, scr, r, lane); continue; } r -= I_UP;
            transpose_item<0>(p.w_down + (size_t)l * FF_ * D_, FF_, D_, D_, (bf16_t*)(WL + OF_WDN), nullptr, scr, r, lane);
        }
        for (int mrow = gw; mrow < T_ + MEM_; mrow += NGW) {
            const bool ism = mrow >= T_; const float* src = ism ? p.mem + (size_t)(mrow - T_) * D_ : p.x + (size_t)mrow * D_;
            bf16_t* dst = ism ? MEMB + (size_t)(mrow - T_) * D_ : HB + (size_t)mrow * D_;
            f32x4 v[8]; float s = 0.f;
#pragma unroll
            for (int j = 0; j < 8; ++j) { v[j] = *(const f32x4*)(src + 256 * j + 4 * lane); s += (v[j][0] * v[j][0] + v[j][1] * v[j][1]) + (v[j][2] * v[j][2] + v[j][3] * v[j][3]); }
            s = wave_sum(s, lane);
            float sc = 1.f; if (ism) sc = rsqrtf(s * (1.f / D_) + EPS); else if (lane == 0) ssq[mrow] = (u64)__float2ull_rn(s * SSQ_SCALE);
#pragma unroll
            for (int j = 0; j < 8; ++j) { u32x2 w2; w2.x = cvt_pk_bf16(v[j][0] * sc, v[j][1] * sc); w2.y = cvt_pk_bf16(v[j][2] * sc, v[j][3] * sc); *(u32x2*)(dst + 256 * j + 4 * lane) = w2; }
        }
        for (int i = c * 512 + tid; i < 12 * T_; i += G * 512) ssq[T_ + i] = 0ull;
        if (c == 0 && tid < 16) KNB[tid] = 0u;
        if (c == 1) for (int i = tid; i < 2 * D_ / 2; i += 512) ((unsigned*)HB)[i - 2 * D_ / 2] = 0u;
    }
    GSYNC;
#pragma unroll 1
    for (int l = 0; l < L_; ++l) {
        if (PH(1)) REPS(1) { PHB
            SchedIn S{ws, l, (l == 0) ? 16 : 0, G, c};
            EpiB E;
            pg8::gemm_phase<EpiB, SchedIn>(lds, tid, D_, S, E);
        }
        GSYNC;
        if (PH(2)) REPS(2) { PHB
            for (int u = c; u < 4 + 512 + 64; u += G) {
                if (u < 4) {
                    const int hd = u; const float bf = p.b_fox_f[l * 4 + hd];
                    LAS float* wt = (LAS float*)lds;
                    float pre[16]; float run = 0.f;
#pragma unroll
                    for (int j = 0; j < 16; ++j) { run += logsig(GATES[(size_t)(tid * 16 + j) * 32 + hd] + bf); pre[j] = run; }
                    float xs = run;
#pragma unroll
                    for (int off = 1; off < 64; off <<= 1) { const float y = __int_as_float(__builtin_amdgcn_ds_bpermute((lane >= off ? lane - off : lane) << 2, __float_as_int(xs))); if (lane >= off) xs += y; }
                    if (lane == 63) wt[wave] = xs;
                    __syncthreads();
                    float base = 0.f;
#pragma unroll
                    for (int g = 0; g < 8; ++g) if (g < wave) base += wt[g];
                    const float excl = base + xs - run;
#pragma unroll
                    for (int j = 0; j < 16; ++j) CC[(size_t)hd * T_ + tid * 16 + j] = excl + pre[j];
                    __syncthreads();
                } else if (u < 516) {
                    const int v = u - 4; gla_unit<0>(lds, tid, p, l, v >> 7, v & 127);
                } else {
                    const int v = u - 516, hd = v >> 4, sl = v & 15; float mxn = 0.f;
#pragma unroll 4
                    for (int ps = 0; ps < 16; ++ps) {
                        const int key = sl * 512 + ps * 32 + (tid >> 4);
                        const u32x4 kk = *(const u32x4*)(PROJ + (size_t)key * NP + PJ_FK + hd * 128 + (tid & 15) * 8);
                        float q2 = bflo(kk.x) * bflo(kk.x) + bfhi(kk.x) * bfhi(kk.x) + bflo(kk.y) * bflo(kk.y) + bfhi(kk.y) * bfhi(kk.y) + bflo(kk.z) * bflo(kk.z) + bfhi(kk.z) * bfhi(kk.z) + bflo(kk.w) * bflo(kk.w) + bfhi(kk.w) * bfhi(kk.w);
                        q2 += shx(q2, 1, lane); q2 += shx(q2, 2, lane); q2 += shx(q2, 4, lane); q2 += shx(q2, 8, lane);
                        mxn = fmaxf(mxn, q2);
                    }
                    mxn = fmaxf(mxn, shx(mxn, 16, lane)); mxn = fmaxf(mxn, shx(mxn, 32, lane));
                    if (lane == 0) atomicMax(KNB + l * 4 + hd, __float_as_uint(mxn));
                }
            }
        }
        GSYNC;
        if (PH(3)) { PHB
            if (c < 128) {
                const int u = c;

                    const int qb = 31 - (u >> 2), hd = u & 3, tq0 = 256 * qb + 32 * wave, t_row = tq0 + (lane & 31);
                    attn_unit<0>(lds, tid, PROJ + (size_t)t_row * NP + PJ_FQ + hd * 128, PROJ + PJ_FK + hd * 128, NP, VT + (size_t)(VT_F + hd * 128) * T_, T_,
                                 0, 4 * (qb + 1), t_row, tq0, CC + (size_t)hd * T_, NEG, 0.f, nullptr, O + (size_t)t_row * D_ + hd * 128, sqrtf(__uint_as_float(KNB[l * 4 + hd])));
            } else {
                const int cc = c - 128;
                LAS float* t5 = (LAS float*)(lds + AT_T5);
            for (int i = tid; i < 1024; i += 512) { const int hd = i >> 7, n = i & 127;
                int bk = n; if (n >= 16) { bk = 16 + (int)(__logf((float)n / 16.f) / __logf(8.f) * 16.f); bk = bk < 31 ? bk : 31; }
                t5[i] = p.t5_bias[bk * 8 + hd] * LOG2E; }
            __syncthreads();
                if (cc < 64) {
                    const int u = cc + 128;
                    const int v = u - 128, hh = v >> 4, e = (v & 15) * 512 + tid, dk = tid & 63;
                    float* kp = KVB + (size_t)hh * 128 * 8192 + e; const float* dp = DEC + (size_t)hh * 128 * 64 + dk;
                    float S = 0.f;
                    for (int n0 = 0; n0 < 128; n0 += 32) {
                        float kvv[32], dd[32];
#pragma unroll
                        for (int j = 0; j < 32; ++j) { kvv[j] = kp[(size_t)(n0 + j) * 8192]; dd[j] = dp[(n0 + j) * 64]; }
#pragma unroll
                        for (int j = 0; j < 32; ++j) { kp[(size_t)(n0 + j) * 8192] = S; S = dd[j] * S + kvv[j]; }
                    }
                    asm volatile("s_waitcnt vmcnt(0)" ::: "memory"); __syncthreads();
                    if (tid == 0) { __builtin_amdgcn_fence(__ATOMIC_RELEASE, "agent"); asm volatile("s_waitcnt vmcnt(0)" ::: "memory");
                        (void)__hip_atomic_fetch_add((unsigned*)ws + 3584 + 64 * l, 1u, __ATOMIC_RELAXED, __HIP_MEMORY_SCOPE_AGENT); }
                }
                for (int si = 0; si < (cc < 64 ? 1 : 3); ++si) {
                    const int su = cc < 64 ? cc : 64 + (cc - 64) * 3 + si;
                    const int v = su, kvh = v >> 7, n = (v >> 1) & 63, pr = v & 1;
                    const int hl = wave >> 2, qh = kvh * 4 + pr * 2 + hl, tq0 = 128 * n + 32 * (wave & 3), t_row = tq0 + (lane & 31);
                    attn_unit<1>(lds, tid, PROJ + (size_t)t_row * NP + PJ_SQ + qh * 128, PROJ + PJ_SK + kvh * 128, NP, VT + (size_t)(VT_S + kvh * 128) * T_, T_,
                                 (2 * n - 2) < 0 ? 0 : (2 * n - 2), 2 * n + 2, t_row, tq0, nullptr, p.swa_sinks[l * 8 + qh] * LOG2E, 1.f, t5 + qh * 128,
                                 O + (size_t)t_row * D_ + 512 + qh * 128);
                }
            }
            if (tid == 0) { unsigned* cw_ = (unsigned*)ws + 3584 + 64 * l; unsigned sp_ = 0;
                while (__hip_atomic_load(cw_, __ATOMIC_RELAXED, __HIP_MEMORY_SCOPE_AGENT) < 64u) { __builtin_amdgcn_s_sleep(2); if (++sp_ > (1u << 22)) break; }
                __builtin_amdgcn_fence(__ATOMIC_ACQUIRE, "agent"); asm volatile("s_waitcnt vmcnt(0)" ::: "memory"); }
            __syncthreads();
            for (int u = c; u < 512; u += G) gla_unit<1>(lds, tid, p, l, u >> 7, u & 127);
        }
        GSYNC;
        if (PH(5)) { PHB
            SchedR S{(const char*)O, (const char*)(WL + OF_WOUT), D_, G, c};
            EpiR E{HB, ssq + (3 * l + 1) * T_, (LAS float*)(lds + 131072)};
            pg8::gemm_phase<EpiR, SchedR>(lds, tid, D_, S, E);
        }
        GSYNC;
        if (PH(6)) REPS(6) { PHB
            SchedQH S{ws, l, G, c};
            EpiB E;
            pg8::gemm_phase<EpiB, SchedQH, false, true>(lds, tid, D_, S, E);
            if (c < 128) {
                asm volatile("s_waitcnt vmcnt(0)" ::: "memory"); __syncthreads();
                const int hd = c >> 5, qb = c & 31, tq0 = 256 * qb + 32 * wave, t_row = tq0 + (lane & 31);
                attn_unit<2>(lds, tid, QX + (size_t)t_row * 512 + hd * 128, KX + (size_t)l * 256 * 512 + hd * 128, 512, VXT + (size_t)l * 512 * 256 + (size_t)hd * 128 * 256, 256,
                             0, 4, t_row, tq0, nullptr, NEG, 0.f, nullptr, XO + (size_t)t_row * 512 + hd * 128);
            }
        }
        GSYNC;
        if (PH(8)) { PHB
            SchedR S{(const char*)XO, (const char*)(WL + OF_WO), 512, G, c};
            EpiR E{HB, ssq + (3 * l + 2) * T_, (LAS float*)(lds + 131072)};
            pg8::gemm_phase<EpiR, SchedR>(lds, tid, 512, S, E);
        }
        GSYNC;
        if (PH(9)) REPS(9) { PHB
            SchedUp S{ws, l, G, c};
            EpiC E{p, ws, l, (LAS float*)(lds + 131072)};
            pg8::gemm_phase<EpiC, SchedUp, true>(lds, tid, D_, S, E);
        }
        GSYNC;
        if (PH(11)) { PHB
            SchedR S{(const char*)ACT, (const char*)(WL + OF_WDN), FF_, G, c};
            EpiR E{HB, ssq + (3 * l + 3) * T_, (LAS float*)(lds + 131072)};
            pg8::gemm_phase<EpiR, SchedR>(lds, tid, FF_, S, E);
        }
        GSYNC;
    }
    if (PH(12)) { PHB
        const u64* sq = ssq + 12 * T_;
        for (int row = c * 8 + wave; row < T_; row += G * 8) {
            const float rs = rsqrtf(u64f(sq[row]) * SSQ_INV + EPS);
#pragma unroll
            for (int j = 0; j < 8; ++j) { const u32x2 hv = *(const u32x2*)(HB + (size_t)row * D_ + 256 * j + 4 * lane); const f32x4 g = *(const f32x4*)(p.final_norm + 256 * j + 4 * lane);
                *(f32x4*)(p.out + (size_t)row * D_ + 256 * j + 4 * lane) = (f32x4){bflo(hv.x), bfhi(hv.x), bflo(hv.y), bfhi(hv.y)} * rs * g; }
        }
    }
}

extern "C" void kernel_launch(void* const* d_in, const int* in_sizes, int n_in, void* d_out, int out_size, void* d_ws, size_t ws_size, hipStream_t stream) {
    static int grid = 0;
    if (grid == 0) {
        if (n_in != 22 || ws_size < WS_END) { fprintf(stderr, "kernel_launch: unexpected n_in %d or ws_size %zu (< %zu)\n", n_in, ws_size, (size_t)WS_END); grid = -1; return; }
        int dev = 0, cus = 0, per_cu = 0;
        hipGetDevice(&dev); hipDeviceGetAttribute(&cus, hipDeviceAttributeMultiprocessorCount, dev);
        if (hipFuncSetAttribute((const void*)hybrid_fwd, hipFuncAttributeMaxDynamicSharedMemorySize, LDS_BYTES) != hipSuccess) { fprintf(stderr, "kernel_launch: hipFuncSetAttribute failed\n"); grid = -1; return; }
        hipOccupancyMaxActiveBlocksPerMultiprocessor(&per_cu, (const void*)hybrid_fwd, 512, LDS_BYTES);
        (void)hipGetLastError();
        if (per_cu < 1) { fprintf(stderr, "kernel_launch: occupancy query says %d\n", per_cu); per_cu = 1; }
        grid = cus * per_cu;
    }
    if (grid < 0) return;
    Params p{};
    const float** pp = (const float**)&p;
    for (int i = 0; i < 22; ++i) pp[i] = (const float*)d_in[i];
    p.out = (float*)d_out; p.ws = (unsigned char*)d_ws;
    if (hipMemsetAsync(d_ws, 0, 16384, stream) != hipSuccess) { fprintf(stderr, "kernel_launch: hipMemsetAsync of the barrier words failed\n"); return; }
    void* args[] = {&p};
    hipError_t e = hipLaunchCooperativeKernel((const void*)hybrid_fwd, dim3(grid), dim3(512), args, LDS_BYTES, stream);
    if (e != hipSuccess) fprintf(stderr, "cooperative launch failed: %s (grid %d)\n", hipGetErrorString(e), grid);
}
```
